# Optimizing an MI355X kernel written in HIP

```python
import math
import jax
import jax.numpy as jnp
from jax import lax
import numpy as np

D_MODEL = 2048
BATCH = 2
SEQ = 16384
DEPTH = 2

N_META = 16
EPS = 1e-6
ROPE_THETA = 500000.0
ROPE_FRACTION = 4

LRU_WIDTH = D_MODEL // 2
LRU_BLOCKS = 4
LRU_BLOCK = LRU_WIDTH // LRU_BLOCKS
CONV_W = 4
LRU_C = 8.0

GLA_HEADS = 4
GLA_DV = (D_MODEL // 2) // GLA_HEADS
GLA_DK = GLA_DV // 2
GLA_RANK = 16
GLA_GATE_NORM = 16.0
GLA_CHUNK = 64

ATT_HEADS = 16
ATT_KV_HEADS = 4
HEAD_DIM = D_MODEL // ATT_HEADS
ATT_GROUPS = ATT_HEADS // ATT_KV_HEADS
IDX_HEADS = 8
IDX_DIM = 64
TOPK_MAX = 256
Q_BLOCK = 128
BIG = 1e30
NEG = -1e30

D_FF = ((8 * D_MODEL // 3 + 255) // 256) * 256
N_EXPERTS = 8
TOP_K_EXPERTS = 2
D_EXPERT = 7 * D_MODEL // 2
MOE_BLOCK = 512

AB_SPLITS = (LRU_WIDTH, LRU_WIDTH, GLA_HEADS * GLA_DK, GLA_HEADS * GLA_DK,
             GLA_HEADS * GLA_DV, GLA_HEADS * GLA_DV, GLA_RANK)
D_IN_AB = sum(AB_SPLITS)
C_SPLITS = (ATT_HEADS * HEAD_DIM, ATT_KV_HEADS * HEAD_DIM, ATT_KV_HEADS * HEAD_DIM,
            IDX_HEADS * IDX_DIM, IDX_DIM, IDX_HEADS)
D_IN_C = sum(C_SPLITS)

kernel_name = "hybrid_rglru_gla_dsa_moe_meta"


def rms_norm(x, g):
    xf = x.astype(jnp.float32)
    y = xf * lax.rsqrt(jnp.mean(xf * xf, axis=-1, keepdims=True) + EPS)
    return (y * g.astype(jnp.float32)).astype(x.dtype)


def split_cols(z, sizes):
    offs = [int(o) for o in np.cumsum(sizes)[:-1]]
    return jnp.split(z, offs, axis=-1)


def partial_rope(x, pos):
    rot = x.shape[-1] // ROPE_FRACTION
    half = rot // 2
    freqs = ROPE_THETA ** (-jnp.arange(half, dtype=jnp.float32) / half)
    ang = pos.astype(jnp.float32)[:, None] * freqs[None, :]
    cos = jnp.cos(ang)[:, None, :]
    sin = jnp.sin(ang)[:, None, :]
    x1 = x[..., :half].astype(jnp.float32)
    x2 = x[..., half:rot].astype(jnp.float32)
    xr = jnp.concatenate([x1 * cos - x2 * sin, x2 * cos + x1 * sin], axis=-1).astype(x.dtype)
    return jnp.concatenate([xr, x[..., rot:]], axis=-1)


def _linear_combine(c1, c2):
    a1, b1 = c1
    a2, b2 = c2
    return a1 * a2, a2 * b1 + b2


def rg_lru(xb, yb, conv_w, conv_b, w_r, b_r, w_i, b_i, lam):
    B, T, W = xb.shape
    xc = lax.conv_general_dilated(
        xb, conv_w[:, None, :].astype(xb.dtype), (1,), ((CONV_W - 1, 0),),
        dimension_numbers=("NWC", "WIO", "NWC"), feature_group_count=W) + conv_b
    xblk = xc.reshape(B, T, LRU_BLOCKS, LRU_BLOCK)
    r = jax.nn.sigmoid(jnp.einsum("btnc,ncd->btnd", xblk, w_r) + b_r).reshape(B, T, W)
    i = jax.nn.sigmoid(jnp.einsum("btnc,ncd->btnd", xblk, w_i) + b_i).reshape(B, T, W)
    log_a = -LRU_C * r.astype(jnp.float32) * jax.nn.softplus(-lam.astype(jnp.float32))
    a = jnp.exp(log_a)
    u = jnp.sqrt(-jnp.expm1(2.0 * log_a)) * (i * xc).astype(jnp.float32)
    _, h = lax.associative_scan(_linear_combine, (a, u), axis=1)
    return h.astype(xb.dtype) * jax.nn.gelu(yb)


def gla(q, k, v, g, glr, w_gk, b_gk, norm_g):
    B, T, _ = q.shape
    H, C = GLA_HEADS, GLA_CHUNK
    gk = jax.nn.log_sigmoid((glr @ w_gk + b_gk).astype(jnp.float32)) / GLA_GATE_NORM
    pad = (-T) % C
    n_c = (T + pad) // C

    def chunks(a, d):
        a = jnp.pad(a.astype(jnp.float32), ((0, 0), (pad, 0), (0, 0)))
        return a.reshape(B, n_c, C, H, d).transpose(1, 0, 3, 2, 4)

    qc = chunks(q, GLA_DK) * (GLA_DK ** -0.5)
    kc = chunks(k, GLA_DK)
    vc = chunks(v, GLA_DV)
    gc = chunks(gk, GLA_DK)
    tri = jnp.tril(jnp.ones((C, C), dtype=bool))

    def step(S, inp):
        qq, kk, vv, gg = inp
        bcum = jnp.cumsum(gg, axis=-2)
        inter = jnp.einsum("bhtd,bhde->bhte", qq * jnp.exp(bcum), S)
        diff = bcum[:, :, :, None, :] - bcum[:, :, None, :, :]
        decay = jnp.where(tri[:, :, None], jnp.exp(jnp.minimum(diff, 0.0)), 0.0)
        att = jnp.einsum("bhtd,bhsd,bhtsd->bhts", qq, kk, decay)
        intra = jnp.einsum("bhts,bhse->bhte", att, vv)
        blast = bcum[:, :, -1:, :]
        S_new = (jnp.exp(blast[:, :, 0, :])[..., None] * S
                 + jnp.einsum("bhsd,bhse->bhde", kk * jnp.exp(blast - bcum), vv))
        return S_new, inter + intra

    S0 = jnp.zeros((B, H, GLA_DK, GLA_DV), jnp.float32)
    _, o = lax.scan(step, S0, (qc, kc, vc, gc))
    o = o.transpose(1, 0, 3, 2, 4).reshape(B, n_c * C, H, GLA_DV)[:, pad:]
    o = o * lax.rsqrt(jnp.mean(o * o, axis=-1, keepdims=True) + EPS) * norm_g.astype(jnp.float32)
    return o.reshape(B, T, H * GLA_DV).astype(q.dtype) * jax.nn.silu(g)


def mixer_ab(xn, w_in, conv_w, conv_b, w_r, b_r, w_i, b_i, lam, w_gk, b_gk, gla_norm, w_out):
    xb, yb, q, k, v, g, glr = split_cols(xn @ w_in, AB_SPLITS)
    a_out = rg_lru(xb, yb, conv_w, conv_b, w_r, b_r, w_i, b_i, lam)
    b_out = gla(q, k, v, g, glr, w_gk, b_gk, gla_norm)
    return jnp.concatenate([a_out, b_out], axis=-1) @ w_out


def dsa_attention(xn, w_in, w_out):
    B, T, _ = xn.shape
    q, k, v, qi, ki, wi = split_cols(xn @ w_in, C_SPLITS)
    pos = jnp.arange(T)
    q = partial_rope(q.reshape(B, T, ATT_HEADS, HEAD_DIM), pos)
    k = partial_rope(k.reshape(B, T, ATT_KV_HEADS, HEAD_DIM), pos)
    v = v.reshape(B, T, ATT_KV_HEADS, HEAD_DIM)
    qi = partial_rope(qi.reshape(B, T, IDX_HEADS, IDX_DIM), pos).astype(jnp.float32)
    ki = partial_rope(ki.reshape(B, T, 1, IDX_DIM), pos)[:, :, 0].astype(jnp.float32)
    wi = wi.astype(jnp.float32) * (IDX_HEADS ** -0.5 * IDX_DIM ** -0.5)
    k_sel = min(TOPK_MAX, (T - N_META) // 4)
    n_blk = -(-T // Q_BLOCK)
    t_pad = n_blk * Q_BLOCK
    pad = t_pad - T

    def pad_t(a):
        return jnp.pad(a, ((0, 0), (0, pad)) + ((0, 0),) * (a.ndim - 2))

    q, k, v, qi, ki, wi = pad_t(q), pad_t(k), pad_t(v), pad_t(qi), pad_t(ki), pad_t(wi)
    key_pos = jnp.arange(t_pad)
    is_meta = key_pos < N_META
    bidx = jnp.arange(B)[:, None, None]

    def block(bi):
        t0 = bi * Q_BLOCK
        qb = lax.dynamic_slice_in_dim(q, t0, Q_BLOCK, axis=1)
        qib = lax.dynamic_slice_in_dim(qi, t0, Q_BLOCK, axis=1)
        wib = lax.dynamic_slice_in_dim(wi, t0, Q_BLOCK, axis=1)
        qpos = t0 + jnp.arange(Q_BLOCK)
        logits = jnp.einsum("bqhd,bsd->bqhs", qib, ki)
        score = jnp.einsum("bqh,bqhs->bqs", wib, jax.nn.relu(logits))
        causal = key_pos[None, :] <= qpos[:, None]
        score = jnp.where(causal, jnp.where(is_meta, BIG, score), NEG)
        vals, idx = lax.top_k(score, k_sel)
        valid = vals > 0.5 * NEG
        kg = k[bidx, idx]
        vg = v[bidx, idx]
        qg = qb.reshape(B, Q_BLOCK, ATT_KV_HEADS, ATT_GROUPS, HEAD_DIM)
        s = jnp.einsum("bqhgd,bqkhd->bqhgk", qg, kg).astype(jnp.float32) * (HEAD_DIM ** -0.5)
        s = jnp.where(valid[:, :, None, None, :], s, NEG)
        p = jax.nn.softmax(s, axis=-1).astype(vg.dtype)
        o = jnp.einsum("bqhgk,bqkhd->bqhgd", p, vg)
        return o.reshape(B, Q_BLOCK, ATT_HEADS * HEAD_DIM)

    o = lax.map(block, jnp.arange(n_blk))
    o = o.transpose(1, 0, 2, 3).reshape(B, t_pad, ATT_HEADS * HEAD_DIM)[:, :T]
    return o @ w_out


def swiglu(xn, w_gate, w_up, w_down):
    return (jax.nn.silu(xn @ w_gate) * (xn @ w_up)) @ w_down


def moe_ffn(xn, w_router, w_gate, w_up, w_down):
    B, T, D = xn.shape
    N = B * T
    xf = xn.reshape(N, D)
    logits = (xf @ w_router).astype(jnp.float32)
    top_vals, top_idx = lax.top_k(logits, TOP_K_EXPERTS)
    gates = jax.nn.softmax(top_vals, axis=-1)
    n_assign = N * TOP_K_EXPERTS
    e_flat = top_idx.reshape(-1)
    tok_flat = jnp.repeat(jnp.arange(N, dtype=jnp.int32), TOP_K_EXPERTS)
    g_flat = gates.reshape(-1)
    order = jnp.argsort(e_flat, stable=True)
    e_sorted, tok_sorted, g_sorted = e_flat[order], tok_flat[order], g_flat[order]
    counts = jnp.bincount(e_flat, length=N_EXPERTS)
    padded = (counts + MOE_BLOCK - 1) // MOE_BLOCK * MOE_BLOCK
    grp_start = jnp.cumsum(counts) - counts
    pad_end = jnp.cumsum(padded)
    pad_start = pad_end - padded
    dest = pad_start[e_sorted] + (jnp.arange(n_assign) - grp_start[e_sorted])
    n_blocks = -(-n_assign // MOE_BLOCK) + N_EXPERTS
    n_slots = n_blocks * MOE_BLOCK
    slot_tok = jnp.full((n_slots,), N, jnp.int32).at[dest].set(tok_sorted)
    slot_gate = jnp.zeros((n_slots,), jnp.float32).at[dest].set(g_sorted)
    blk_expert = jnp.minimum(
        jnp.searchsorted(pad_end, jnp.arange(n_blocks) * MOE_BLOCK, side="right"), N_EXPERTS - 1)
    x_pad = jnp.concatenate([xf, jnp.zeros((1, D), xf.dtype)], axis=0)

    def expert_block(args):
        tok, e = args
        xb = x_pad[tok]
        return swiglu(xb, w_gate[e], w_up[e], w_down[e])

    y = lax.map(expert_block, (slot_tok.reshape(n_blocks, MOE_BLOCK), blk_expert))
    y = y.reshape(n_slots, D) * slot_gate[:, None].astype(y.dtype)
    out = jnp.zeros((N + 1, D), y.dtype).at[slot_tok].add(y)[:N]
    return out.reshape(B, T, D)


def setup_inputs(seed: int = 0) -> dict:
    key = jax.random.key(seed)
    ks = list(jax.random.split(key, 32))
    f32 = jnp.float32
    ne = (DEPTH + 1) // 2
    no = DEPTH // 2

    def nrm(shape, fan_in):
        return jax.random.normal(ks.pop(), shape, f32) * (fan_in ** -0.5)

    def gain(shape):
        return 1.0 + 0.02 * jax.random.normal(ks.pop(), shape, f32)

    def bias(shape, s=0.02):
        return s * jax.random.normal(ks.pop(), shape, f32)

    x = jax.random.normal(ks.pop(), (BATCH, SEQ, D_MODEL), f32)
    meta = jax.random.normal(ks.pop(), (N_META, D_MODEL), f32)
    a0 = jax.random.uniform(ks.pop(), (ne, LRU_WIDTH), f32, minval=0.9, maxval=0.999)
    lru_lam = jnp.log(a0) - jnp.log1p(-a0)
    return {
        "x": x,
        "meta": meta,
        "ab_norm": gain((ne, D_MODEL)),
        "ab_w_in": nrm((ne, D_MODEL, D_IN_AB), D_MODEL),
        "lru_conv_w": nrm((ne, CONV_W, LRU_WIDTH), CONV_W),
        "lru_conv_b": bias((ne, LRU_WIDTH)),
        "lru_w_r": nrm((ne, LRU_BLOCKS, LRU_BLOCK, LRU_BLOCK), LRU_BLOCK),
        "lru_b_r": bias((ne, LRU_BLOCKS, LRU_BLOCK)),
        "lru_w_i": nrm((ne, LRU_BLOCKS, LRU_BLOCK, LRU_BLOCK), LRU_BLOCK),
        "lru_b_i": bias((ne, LRU_BLOCKS, LRU_BLOCK)),
        "lru_lam": lru_lam,
        "gla_w_gk": nrm((ne, GLA_RANK, GLA_HEADS * GLA_DK), GLA_RANK),
        "gla_b_gk": bias((ne, GLA_HEADS * GLA_DK), 0.1),
        "gla_norm": gain((ne, GLA_DV)),
        "ab_w_out": nrm((ne, D_MODEL, D_MODEL), D_MODEL),
        "ffn_norm": gain((ne, D_MODEL)),
        "ffn_w_gate": nrm((ne, D_MODEL, D_FF), D_MODEL),
        "ffn_w_up": nrm((ne, D_MODEL, D_FF), D_MODEL),
        "ffn_w_down": nrm((ne, D_FF, D_MODEL), D_FF),
        "c_norm": gain((no, D_MODEL)),
        "c_w_in": nrm((no, D_MODEL, D_IN_C), D_MODEL),
        "c_w_out": nrm((no, D_MODEL, D_MODEL), D_MODEL),
        "moe_norm": gain((no, D_MODEL)),
        "moe_router": nrm((no, D_MODEL, N_EXPERTS), D_MODEL),
        "moe_w_gate": nrm((no, N_EXPERTS, D_MODEL, D_EXPERT), D_MODEL),
        "moe_w_up": nrm((no, N_EXPERTS, D_MODEL, D_EXPERT), D_MODEL),
        "moe_w_down": nrm((no, N_EXPERTS, D_EXPERT, D_MODEL), D_EXPERT),
        "final_norm": gain((D_MODEL,)),
    }


def reference(x, meta, ab_norm, ab_w_in, lru_conv_w, lru_conv_b, lru_w_r, lru_b_r,
              lru_w_i, lru_b_i, lru_lam, gla_w_gk, gla_b_gk, gla_norm, ab_w_out,
              ffn_norm, ffn_w_gate, ffn_w_up, ffn_w_down, c_norm, c_w_in, c_w_out,
              moe_norm, moe_router, moe_w_gate, moe_w_up, moe_w_down, final_norm):
    B = x.shape[0]
    h = jnp.concatenate(
        [jnp.broadcast_to(meta.astype(x.dtype)[None], (B, N_META, x.shape[-1])), x], axis=1)
    for layer in range(DEPTH):
        i = layer // 2
        if layer % 2 == 0:
            h = h + mixer_ab(rms_norm(h, ab_norm[i]), ab_w_in[i], lru_conv_w[i], lru_conv_b[i],
                             lru_w_r[i], lru_b_r[i], lru_w_i[i], lru_b_i[i], lru_lam[i],
                             gla_w_gk[i], gla_b_gk[i], gla_norm[i], ab_w_out[i])
            h = h + swiglu(rms_norm(h, ffn_norm[i]), ffn_w_gate[i], ffn_w_up[i], ffn_w_down[i])
        else:
            h = h + dsa_attention(rms_norm(h, c_norm[i]), c_w_in[i], c_w_out[i])
            h = h + moe_ffn(rms_norm(h, moe_norm[i]), moe_router[i], moe_w_gate[i],
                            moe_w_up[i], moe_w_down[i])
    return rms_norm(h, final_norm)[:, N_META:]
```

```cpp
#include <hip/hip_runtime.h>
#include <cstdio>
#include <cstdint>

#define GAS __attribute__((address_space(1)))
#define LAS __attribute__((address_space(3)))
typedef unsigned short bf16;
typedef unsigned v4u __attribute__((ext_vector_type(4)));
typedef unsigned v2u __attribute__((ext_vector_type(2)));
typedef float f32x4 __attribute__((ext_vector_type(4)));
typedef float f32x2 __attribute__((ext_vector_type(2)));
typedef short bf16x8 __attribute__((ext_vector_type(8)));

#ifndef N_LAUNCH_MODE
#define N_LAUNCH_MODE 1
#endif

constexpr int D = 2048, SEQ = 16384, NMETA = 16, TT = 16400;
constexpr int MS = 32768;
constexpr int MR = 32784;
constexpr int MP = 33024;
constexpr int NAB = 5136, NABP = 5376, NC = 3656, NCP = 3840, DFF = 5632, DEXP = 7168;
constexpr int GLA_UNITS = 4 + 2 * 256 * 4;
constexpr int MOE_PASS_TILES = 88;
constexpr float EPS = 1e-6f;

constexpr size_t MiB = 1u << 20;
constexpr size_t WS_CTL = 0;
constexpr size_t WS_HMPAD = 1 * MiB;
constexpr size_t WS_ROPE = 3 * MiB;
constexpr size_t WS_LSUM = 6 * MiB;
constexpr size_t WS_DEC = 8 * MiB;
constexpr size_t WS_WIS = 10 * MiB;
constexpr size_t WS_MOET = 12 * MiB;
constexpr size_t WS_TOP = 13 * MiB;
constexpr size_t WS_WINC = 14 * MiB;
constexpr size_t WS_WOUTC = 29 * MiB;
constexpr size_t WS_XN = 37 * MiB;
constexpr size_t WS_WM = 166 * MiB;
constexpr size_t WS_WMGU = WS_WM, WS_WMD = WS_WM + 448 * MiB;
constexpr size_t WS_R = 838 * MiB;
constexpr size_t WS_Z0 = 166 * MiB;
constexpr size_t WS_XC = 505 * MiB;
constexpr size_t WS_RI = 570 * MiB;
constexpr size_t WS_WINAB = WS_R + 0 * MiB;
constexpr size_t WS_WRI = WS_R + 21 * MiB;
constexpr size_t WS_WOUTAB = WS_R + 22 * MiB;
constexpr size_t WS_WGU = WS_R + 30 * MiB;
constexpr size_t WS_WDOWN = WS_R + 74 * MiB;
constexpr size_t WS_MIX = WS_R + 96 * MiB;
constexpr size_t WS_DST = WS_R + 225 * MiB;
constexpr size_t WS_ST = WS_R + 482 * MiB;
constexpr size_t WS_ACT = WS_R + 225 * MiB;
constexpr size_t WS_Z1 = WS_R + 0 * MiB;
constexpr size_t WS_KIP = WS_R + 242 * MiB;
constexpr size_t WS_SEL = WS_R + 247 * MiB;
constexpr size_t WS_SELCNT = WS_R + 262 * MiB;
constexpr size_t WS_ATT = WS_R + 263 * MiB;
constexpr size_t WS_XG = WS_R + 0 * MiB;
constexpr size_t WS_ACT2 = WS_R + 264 * MiB;
constexpr size_t WS_Y = WS_R + 572 * MiB;
constexpr size_t WS_END = WS_R + 836 * MiB;
constexpr int MT_BLKCNT = 0;
constexpr int MT_TILEEXP = 8192;
constexpr int MT_NTILES = 8192 + 512;
constexpr int CW_BAR = 4096;

constexpr int LDS_BYTES = 159744;
constexpr int LDS_MISC = 158720;

__device__ __forceinline__ float bf2f(bf16 v) { return __builtin_bit_cast(float, (unsigned)v << 16); }
__device__ __forceinline__ unsigned f2bf(float f) { unsigned u = __builtin_bit_cast(unsigned, f); return (u + 0x7fffu + ((u >> 16) & 1u)) >> 16; }
__device__ __forceinline__ unsigned pk2(float lo, float hi) { return f2bf(lo) | (f2bf(hi) << 16); }
__device__ __forceinline__ float wave_sum(float v) {
#pragma unroll
    for (int o = 1; o < 64; o <<= 1) v += __shfl_xor(v, o);
    return v;
}
#define LDS_WAIT() asm volatile("s_waitcnt lgkmcnt(0)" ::: "memory")
#define VM_WAIT() asm volatile("s_waitcnt vmcnt(0)" ::: "memory")
__device__ __forceinline__ float sigmoidf_(float x) { return 1.0f / (1.0f + __expf(-x)); }
__device__ __forceinline__ float siluf_(float x) { return x / (1.0f + __expf(-x)); }
__device__ __forceinline__ float gelu_tanh(float x) { const float u = 0.7978845608028654f * (x + 0.044715f * x * x * x); return 0.5f * x * (1.0f + tanhf(u)); }
__device__ __forceinline__ unsigned ld_agent(const unsigned* p) { return __hip_atomic_load(p, __ATOMIC_RELAXED, __HIP_MEMORY_SCOPE_AGENT); }

#define XB_TMO      128
#define XB_XCNT(j)  (256  + 64 * (j))
#define XB_XSUB(j)  (1280 + 64 * (j))
#define XB_XGEN(j)  (2304 + 64 * (j))
#define XB_TOP      3328
#define XB_TOPGEN   3392
#define XCD_BAR_WORDS 3456
#define XB_SPIN_CAP (1u << 21)
__device__ __forceinline__ unsigned xb_ld(unsigned* p)              { return __hip_atomic_load(p, __ATOMIC_RELAXED, __HIP_MEMORY_SCOPE_AGENT); }
__device__ __forceinline__ unsigned xb_add(unsigned* p, unsigned v) { return __hip_atomic_fetch_add(p, v, __ATOMIC_RELAXED, __HIP_MEMORY_SCOPE_AGENT); }
__device__ __forceinline__ unsigned xb_xcc_id() { return (unsigned)__builtin_amdgcn_s_getreg((3 << 11) | 20) & 0xFu; }
#define XB_SPIN(cond, bar) do { unsigned _sp = 0; while (cond) { __builtin_amdgcn_s_sleep(1); \
    if ((++_sp & 255u) == 0u) { if (xb_ld(&(bar)[XB_TMO])) break; if (_sp > XB_SPIN_CAP) { atomicAdd(&(bar)[XB_TMO], 1u); break; } } } } while (0)
struct XcdBarrier { unsigned* bar; unsigned x; volatile LAS unsigned* st; };
__device__ __forceinline__ XcdBarrier xcd_barrier_post(unsigned* bar, volatile LAS unsigned* st) {
    XcdBarrier b; b.bar = bar; b.x = xb_xcc_id(); b.st = st;
    if (threadIdx.x == 0) (void)xb_add(&bar[XB_XCNT(b.x)], 1u);
    return b;
}
__device__ __forceinline__ void xcd_barrier_complete(unsigned* bar, unsigned x, unsigned& nloc, unsigned& nx) {
    const unsigned G = gridDim.x * gridDim.y * gridDim.z;
    unsigned sum, cnt, mine, sp = 0u;
    for (;;) {
        sum = 0u; cnt = 0u; mine = 0u;
#pragma unroll
        for (unsigned j = 0; j < 16; ++j) { const unsigned c = xb_ld(&bar[XB_XCNT(j)]); sum += c; cnt += (c > 0u) ? 1u : 0u; mine = (j == x) ? c : mine; }
        if (sum == G) break;
        __builtin_amdgcn_s_sleep(1);
        if ((++sp & 255u) == 0u) { if (xb_ld(&bar[XB_TMO])) break; if (sp > XB_SPIN_CAP) { atomicAdd(&bar[XB_TMO], 1u); break; } }
    }
    nloc = mine > 0u ? mine : 1u; nx = cnt > 0u ? cnt : 1u;
}
__device__ __forceinline__ void xcd_barrier(const XcdBarrier& b) {
    asm volatile("s_waitcnt vmcnt(0)" ::: "memory");
    __syncthreads();
    if (threadIdx.x == 0) {
        unsigned* bar = b.bar;
        __builtin_amdgcn_s_waitcnt(0);
        unsigned nloc = b.st[0], nx = b.st[1];
        if (nloc == 0u) { xcd_barrier_complete(bar, b.x, nloc, nx); b.st[0] = nloc; b.st[1] = nx; }
        const unsigned old = xb_add(&bar[XB_XSUB(b.x)], 1u);
        const unsigned gen = old / nloc;
        if (old + 1u == (gen + 1u) * nloc) {
            __builtin_amdgcn_fence(__ATOMIC_RELEASE, "agent");
            asm volatile("s_waitcnt vmcnt(0)" ::: "memory");
            const unsigned og = xb_add(&bar[XB_TOP], 1u);
            const unsigned tg = og / nx;
            if (og + 1u == (tg + 1u) * nx) xb_add(&bar[XB_TOPGEN], 1u);
            else XB_SPIN(xb_ld(&bar[XB_TOPGEN]) == tg, bar);
            __builtin_amdgcn_fence(__ATOMIC_ACQUIRE, "agent");
            xb_add(&bar[XB_XGEN(b.x)], 1u);
            asm volatile("s_waitcnt vmcnt(0)" ::: "memory");
        } else {
            XB_SPIN(xb_ld(&bar[XB_XGEN(b.x)]) == gen, bar);
            __builtin_amdgcn_fence(__ATOMIC_ACQUIRE, "agent");
            asm volatile("s_waitcnt vmcnt(0)" ::: "memory");
        }
    }
    __syncthreads();
}

struct Args { const float* in[28]; float* out; unsigned char* ws; int ph_lo, ph_hi; };
struct Ctx {
    const float* const* in; float* out; unsigned char* ws; LAS unsigned char* lds;
    int tid, lane, wave, G, bid;
};
enum { I_X = 0, I_META, I_ABNORM, I_ABWIN, I_CONVW, I_CONVB, I_WR, I_BR, I_WI, I_BI, I_LAM, I_WGK, I_BGK, I_GLANORM, I_ABWOUT,
       I_FFNNORM, I_FFNG, I_FFNU, I_FFND, I_CNORM, I_CWIN, I_CWOUT, I_MOENORM, I_ROUTER, I_MOEG, I_MOEU, I_MOED, I_FINALNORM };

__device__ __forceinline__ int row_of(int b, int t) { return t < NMETA ? MS + t : b * SEQ + (t - NMETA); }

namespace gm {
constexpr int BM = 256, BK = 64, HALF = 128, HTB = HALF * BK * 2, STAGE_BYTES = 8 * HTB, NXCD = 8, WGM = 8;
__device__ __forceinline__ int lds_byte(int r, int c) { const int st = (r >> 4) * 2 + (c >> 5), rr = r & 15, cc = c & 31, ob = rr * 64 + cc * 2; return st * 1024 + (ob ^ (((ob >> 9) & 1) << 5)); }
__device__ __forceinline__ void stage_rc(int b, int& R, int& C) { const int st = b / 1024, sb = b % 1024, swz = sb ^ (((sb >> 9) & 1) << 5); R = (st >> 1) * 16 + swz / 64; C = (st & 1) * 32 + (swz % 64) / 2; }
__device__ __forceinline__ int perm32(int rho) { const int n = rho >> 4, i = rho & 15; return 8 * (i >> 2) + 4 * n + (i & 3); }
struct Unit { int pm, pn, aux; };
__device__ __forceinline__ bool tile_order(int i, int G, int c, int nM, int nN, int& pm, int& pn) {
    const int nwg = nM * nN; const long L = (long)i * G + c; if (L >= nwg) return false;
    int wgid = (int)L; { const int q = nwg / NXCD, r = nwg % NXCD, xcd = wgid % NXCD, off = wgid / NXCD; wgid = (xcd < r ? xcd * (q + 1) : r * (q + 1) + (xcd - r) * q) + off; }
    const int nig = WGM * nN, gid = wgid / nig, fm = gid * WGM, gsz = (nM - fm) < WGM ? (nM - fm) : WGM;
    pm = fm + ((wgid % nig) % gsz); pn = (wgid % nig) / gsz; return true;
}
struct DenseSched {
    int nM, nN, G, c; const char* A; const char* B; unsigned lda, ldb; int gate_mode;
    __device__ __forceinline__ bool next(int i, Unit& u) const { u.aux = 0; return tile_order(i, G, c, nM, nN, u.pm, u.pn); }
    __device__ __forceinline__ const char* a_ptr(const Unit& u) const { return A + (size_t)u.pm * 256 * lda + (gate_mode ? (size_t)(u.pn >> 1) * 512 : 0); }
    __device__ __forceinline__ const char* b_ptr(const Unit& u) const { return B + (size_t)u.pn * 256 * ldb; }
};
struct MoeSched {
    int nM, nN, G, c; const char* A; unsigned lda; int a_tile0; const char* B; unsigned ldb; size_t bexp; const unsigned* tile_expert; int t0;
    __device__ __forceinline__ bool next(int i, Unit& u) const {
        if (!tile_order(i, G, c, nM, nN, u.pm, u.pn)) return false;
        u.aux = (int)__builtin_amdgcn_readfirstlane(ld_agent(tile_expert + t0 + u.pm)) & 7; return true; }
    __device__ __forceinline__ const char* a_ptr(const Unit& u) const { return A + (size_t)(a_tile0 + u.pm) * 256 * lda; }
    __device__ __forceinline__ const char* b_ptr(const Unit& u) const { return B + (size_t)u.aux * bexp + (size_t)u.pn * 256 * ldb; }
};

struct EpiBf16 {
    static constexpr bool PERM = true;
    bf16* O; int ldc; int row_off;
    __device__ __forceinline__ void operator()(const f32x4 (&acc)[2][2][4][2], const Unit& u, int wr, int wc, int fr, int fq) const {
        const int row0 = row_off + u.pm * BM + wr * 64 + fr, col0 = u.pn * BM + wc * 32 + 8 * fq;
#pragma unroll
        for (int ai = 0; ai < 2; ++ai)
#pragma unroll
            for (int m = 0; m < 4; ++m) { bf16* rowp = O + (size_t)(row0 + ai * HALF + m * 16) * ldc + col0;
#pragma unroll
                for (int bj = 0; bj < 2; ++bj) { const f32x4 v0 = acc[ai][bj][m][0], v1 = acc[ai][bj][m][1];
                    v4u w; w.x = pk2(v0[0], v0[1]); w.y = pk2(v0[2], v0[3]); w.z = pk2(v1[0], v1[1]); w.w = pk2(v1[2], v1[3]);
                    *(v4u*)(rowp + bj * HALF) = w; } }
    }
};
struct EpiSwiglu {
    static constexpr bool PERM = true;
    bf16* O; int ldc;
    __device__ __forceinline__ void operator()(const f32x4 (&acc)[2][2][4][2], const Unit& u, int wr, int wc, int fr, int fq) const {
        const int row0 = u.pm * BM + wr * 64 + fr, col0 = u.pn * HALF + wc * 32 + 8 * fq;
#pragma unroll
        for (int ai = 0; ai < 2; ++ai)
#pragma unroll
            for (int m = 0; m < 4; ++m) { bf16* rowp = O + (size_t)(row0 + ai * HALF + m * 16) * ldc + col0;
                float o[8];
#pragma unroll
                for (int n = 0; n < 2; ++n)
#pragma unroll
                    for (int j = 0; j < 4; ++j) o[4 * n + j] = siluf_(acc[ai][0][m][n][j]) * acc[ai][1][m][n][j];
                v4u w; w.x = pk2(o[0], o[1]); w.y = pk2(o[2], o[3]); w.z = pk2(o[4], o[5]); w.w = pk2(o[6], o[7]);
                *(v4u*)rowp = w; }
    }
};
struct EpiResid {
    static constexpr bool PERM = false;
    const float* src; float* dst; float* hmpad;
    __device__ __forceinline__ void operator()(const f32x4 (&acc)[2][2][4][2], const Unit& u, int wr, int wc, int fr, int fq) const {
        const bool meta = (u.pm == 128);
        const float* s = meta ? hmpad : src; float* d = meta ? hmpad : dst;
        const int row0 = (meta ? 0 : u.pm * BM) + wr * 64 + fr, col0 = u.pn * BM + wc * 32 + 4 * fq;
#pragma unroll
        for (int ai = 0; ai < 2; ++ai)
#pragma unroll
            for (int m = 0; m < 4; ++m) { const size_t ro = (size_t)(row0 + ai * HALF + m * 16) * D + col0;
#pragma unroll
                for (int bj = 0; bj < 2; ++bj)
#pragma unroll
                    for (int n = 0; n < 2; ++n) { const size_t o = ro + bj * HALF + n * 16; *(f32x4*)(d + o) = *(const f32x4*)(s + o) + acc[ai][bj][m][n]; } }
    }
};

template <class Epi, class Sched>
__device__ __forceinline__ void gemm_phase(LAS unsigned char* lds, const Sched& S, const Epi& E, const int nt, const unsigned lda, const unsigned ldb) {
    const int tid = threadIdx.x, wid = __builtin_amdgcn_readfirstlane(tid >> 6), lane = tid & 63, wr = wid >> 2, wc = wid & 3, fr = lane & 15, fq = lane >> 4;
    unsigned voffA[2], voffB[2];
#pragma unroll
    for (int i = 0; i < 2; ++i) { int R, C; stage_rc(tid * 16 + i * 8192, R, C); const int Rb = Epi::PERM ? ((R & ~31) + perm32(R & 31)) : R;
        voffA[i] = (unsigned)R * lda + (unsigned)C * 2u; voffB[i] = (unsigned)Rb * ldb + (unsigned)C * 2u; }
    const size_t kstep = (size_t)(BK * 2);
    const size_t hstepA = (size_t)HALF * lda, hstepB = (size_t)HALF * ldb;
    const unsigned ldsw = (unsigned)wid * 1024u;
    const int aoff = lds_byte(wr * 64 + fr, fq * 8), boff = lds_byte(wc * 32 + fr, fq * 8);
#define PG8_SA(b, h) (((b) * 2 + (h)) * HTB)
#define PG8_SB(b, h) ((4 + (b) * 2 + (h)) * HTB)
#define PG8_STAGE(bufoff, gbase, voff) do { _Pragma("unroll") for (int _i = 0; _i < 2; ++_i) \
        __builtin_amdgcn_global_load_lds((const unsigned*)((const char*)(gbase) + (voff)[_i]), (LAS unsigned*)(lds + (bufoff) + ldsw + _i * 8192), 16, 0, 0); } while (0)
#define PG8_LDA(dst, b, h) do { _Pragma("unroll") for (int m = 0; m < 4; ++m) _Pragma("unroll") for (int k = 0; k < 2; ++k) dst[m][k] = *(const LAS bf16x8*)(lds + PG8_SA(b, h) + aoff + m * 2048 + k * 1024); } while (0)
#define PG8_LDB(dst, b, h) do { _Pragma("unroll") for (int n = 0; n < 2; ++n) _Pragma("unroll") for (int k = 0; k < 2; ++k) dst[n][k] = *(const LAS bf16x8*)(lds + PG8_SB(b, h) + boff + n * 2048 + k * 1024); } while (0)
#define PG8_MMA(ai, bj, At, Bt) do { __builtin_amdgcn_s_setprio(1); _Pragma("unroll") for (int m = 0; m < 4; ++m) _Pragma("unroll") for (int n = 0; n < 2; ++n) _Pragma("unroll") for (int k = 0; k < 2; ++k) \
        acc[ai][bj][m][n] = __builtin_amdgcn_mfma_f32_16x16x32_bf16(Bt[n][k], At[m][k], acc[ai][bj][m][n], 0, 0, 0); __builtin_amdgcn_s_setprio(0); } while (0)
#define PG8_WAIT_V(n) asm volatile("s_waitcnt vmcnt(" #n ")" ::: "memory")
#define PG8_WAIT_L(n) asm volatile("s_waitcnt lgkmcnt(" #n ")" ::: "memory")
#define PG8_BAR __builtin_amdgcn_s_barrier()
#define PG8_SCHED __builtin_amdgcn_sched_barrier(0)
    Unit cur, nxt; int ui = 0;
    if (!S.next(0, cur)) return;
    f32x4 acc[2][2][4][2];
#pragma unroll
    for (int a = 0; a < 2; ++a)
#pragma unroll
        for (int b = 0; b < 2; ++b)
#pragma unroll
            for (int m = 0; m < 4; ++m)
#pragma unroll
                for (int n = 0; n < 2; ++n) acc[a][b][m][n] = (f32x4){0.f, 0.f, 0.f, 0.f};
    bf16x8 At[4][2], B0[2][2], B1[2][2];
    const char* cA = S.a_ptr(cur); const char* cB = S.b_ptr(cur);
    PG8_STAGE(PG8_SB(0, 0), cB, voffB); PG8_STAGE(PG8_SA(0, 0), cA, voffA); PG8_STAGE(PG8_SB(0, 1), cB + hstepB, voffB); PG8_STAGE(PG8_SA(0, 1), cA + hstepA, voffA);
    if (wr == 1) PG8_BAR;
    PG8_WAIT_V(4); PG8_BAR;
    PG8_STAGE(PG8_SB(1, 0), cB + kstep, voffB); PG8_STAGE(PG8_SA(1, 0), cA + kstep, voffA); PG8_STAGE(PG8_SB(1, 1), cB + hstepB + kstep, voffB);
    PG8_WAIT_V(6); PG8_BAR;
    for (;;) {
        const bool has_next = S.next(ui + 1, nxt);
        const char* nA = has_next ? S.a_ptr(nxt) : cA; const char* nB = has_next ? S.b_ptr(nxt) : cB;
        for (int t = 0; t < nt; t += 2) {
            const bool last = (t == nt - 2);
            const char* a1 = cA + (size_t)(t + 1) * kstep;
            const char* a2 = last ? nA : cA + (size_t)(t + 2) * kstep; const char* b2 = last ? nB : cB + (size_t)(t + 2) * kstep;
            const char* a3 = a2 + kstep; const char* b3 = b2 + kstep;
            PG8_LDB(B0, 0, 0); PG8_SCHED; PG8_LDA(At, 0, 0); PG8_STAGE(PG8_SA(1, 1), a1 + hstepA, voffA);
            PG8_WAIT_L(8); PG8_BAR; PG8_WAIT_L(0); PG8_MMA(0, 0, At, B0); PG8_BAR; PG8_SCHED;
            PG8_LDB(B1, 0, 1); PG8_STAGE(PG8_SB(0, 0), b2, voffB);
            PG8_BAR; PG8_WAIT_L(0); PG8_MMA(0, 1, At, B1); PG8_BAR;
            PG8_LDA(At, 0, 1); PG8_STAGE(PG8_SA(0, 0), a2, voffA);
            PG8_BAR; PG8_WAIT_L(0); PG8_MMA(1, 0, At, B0); PG8_BAR; PG8_SCHED;
            PG8_STAGE(PG8_SB(0, 1), b2 + hstepB, voffB);
            PG8_WAIT_V(6); PG8_BAR; PG8_MMA(1, 1, At, B1); PG8_BAR;
            PG8_LDB(B0, 1, 0); PG8_SCHED; PG8_LDA(At, 1, 0); PG8_STAGE(PG8_SA(0, 1), a2 + hstepA, voffA);
            PG8_WAIT_L(8); PG8_BAR; PG8_WAIT_L(0); PG8_MMA(0, 0, At, B0); PG8_BAR; PG8_SCHED;
            PG8_LDB(B1, 1, 1); PG8_STAGE(PG8_SB(1, 0), b3, voffB);
            PG8_BAR; PG8_WAIT_L(0); PG8_MMA(0, 1, At, B1); PG8_BAR;
            PG8_LDA(At, 1, 1); PG8_STAGE(PG8_SA(1, 0), a3, voffA);
            PG8_BAR; PG8_WAIT_L(0); PG8_MMA(1, 0, At, B0); PG8_BAR; PG8_SCHED;
            PG8_STAGE(PG8_SB(1, 1), b3 + hstepB, voffB);
            PG8_WAIT_V(6); PG8_BAR; PG8_MMA(1, 1, At, B1); PG8_BAR;
        }
        E(acc, cur, wr, wc, fr, fq);
        if (!has_next) break;
#pragma unroll
        for (int a = 0; a < 2; ++a)
#pragma unroll
            for (int b = 0; b < 2; ++b)
#pragma unroll
                for (int m = 0; m < 4; ++m)
#pragma unroll
                    for (int n = 0; n < 2; ++n) acc[a][b][m][n] = (f32x4){0.f, 0.f, 0.f, 0.f};
        cur = nxt; cA = nA; cB = nB; ++ui;
    }
    PG8_WAIT_V(0);
    if (wr == 0) PG8_BAR;
    PG8_BAR;
#undef PG8_SA
#undef PG8_SB
#undef PG8_STAGE
#undef PG8_LDA
#undef PG8_LDB
#undef PG8_MMA
#undef PG8_WAIT_V
#undef PG8_WAIT_L
#undef PG8_BAR
#undef PG8_SCHED
}
}

__device__ __forceinline__ void tr_item(const float* src, int ldsrc, int c0, int nvalid, bf16* dst, int K, int r0, int k0, LAS float* scr, int lane) {
#pragma unroll 8
    for (int i = 0; i < 64; ++i) scr[i * 65 + lane] = (lane < nvalid) ? src[(size_t)(k0 + i) * ldsrc + c0 + lane] : 0.f;
    LDS_WAIT();
    const int c = lane & 7;
#pragma unroll
    for (int j = 0; j < 8; ++j) { const int n = (lane >> 3) + 8 * j; const LAS float* s = scr + (8 * c) * 65 + n;
        v4u o; o.x = pk2(s[0 * 65], s[1 * 65]); o.y = pk2(s[2 * 65], s[3 * 65]); o.z = pk2(s[4 * 65], s[5 * 65]); o.w = pk2(s[6 * 65], s[7 * 65]);
        *(v4u*)(dst + (size_t)(r0 + n) * K + k0 + 8 * c) = o; }
    LDS_WAIT();
}
struct TJob { const float* src; bf16* dst; int N, K, nsg, mode; };
__device__ __forceinline__ void run_job_item(const TJob& j, int item, LAS float* scr, int lane) {
    const int nkb = j.K / 64, sg = item / nkb, kb = item % nkb;
    int nv = j.N - 64 * sg; nv = nv < 0 ? 0 : (nv > 64 ? 64 : nv);
    const int dg = j.mode == 0 ? sg : ((sg >> 1) * 4 + (j.mode == 2 ? 2 : 0) + (sg & 1));
    tr_item(j.src, j.N, 64 * sg, nv, j.dst, j.K, 64 * dg, 64 * kb, scr, lane);
}
__device__ __forceinline__ TJob job_l0(const Ctx& c, int j) {
    TJob t; t.mode = 0;
    if (j == 0) { t.src = c.in[I_ABWIN]; t.dst = (bf16*)(c.ws + WS_WINAB); t.N = NAB; t.K = D; t.nsg = NABP / 64; }
    else if (j <= 4) { const int n = j - 1; t.src = c.in[I_WR] + n * 65536; t.dst = (bf16*)(c.ws + WS_WRI) + (size_t)(n * 512) * 256; t.N = 256; t.K = 256; t.nsg = 4; }
    else if (j <= 8) { const int n = j - 5; t.src = c.in[I_WI] + n * 65536; t.dst = (bf16*)(c.ws + WS_WRI) + (size_t)(n * 512 + 256) * 256; t.N = 256; t.K = 256; t.nsg = 4; }
    else if (j == 9) { t.src = c.in[I_ABWOUT]; t.dst = (bf16*)(c.ws + WS_WOUTAB); t.N = D; t.K = D; t.nsg = 32; }
    else if (j == 10) { t.src = c.in[I_FFNG]; t.dst = (bf16*)(c.ws + WS_WGU); t.N = DFF; t.K = D; t.nsg = 88; t.mode = 1; }
    else if (j == 11) { t.src = c.in[I_FFNU]; t.dst = (bf16*)(c.ws + WS_WGU); t.N = DFF; t.K = D; t.nsg = 88; t.mode = 2; }
    else if (j == 12) { t.src = c.in[I_FFND]; t.dst = (bf16*)(c.ws + WS_WDOWN); t.N = D; t.K = DFF; t.nsg = 32; }
    else if (j == 13) { t.src = c.in[I_CWIN]; t.dst = (bf16*)(c.ws + WS_WINC); t.N = NC; t.K = D; t.nsg = NCP / 64; }
    else { t.src = c.in[I_CWOUT]; t.dst = (bf16*)(c.ws + WS_WOUTC); t.N = D; t.K = D; t.nsg = 32; }
    return t;
}
__device__ __forceinline__ TJob job_moe(const Ctx& c, int j) {
    TJob t; const int e = j / 3, k = j % 3;
    if (k == 0) { t.src = c.in[I_MOEG] + (size_t)e * D * DEXP; t.dst = (bf16*)(c.ws + WS_WMGU) + (size_t)e * 14336 * D; t.N = DEXP; t.K = D; t.nsg = 112; t.mode = 1; }
    else if (k == 1) { t.src = c.in[I_MOEU] + (size_t)e * D * DEXP; t.dst = (bf16*)(c.ws + WS_WMGU) + (size_t)e * 14336 * D; t.N = DEXP; t.K = D; t.nsg = 112; t.mode = 2; }
    else { t.src = c.in[I_MOED] + (size_t)e * DEXP * D; t.dst = (bf16*)(c.ws + WS_WMD) + (size_t)e * D * DEXP; t.N = D; t.K = DEXP; t.nsg = 32; t.mode = 0; }
    return t;
}
__device__ __forceinline__ void rms_row_bf16(const float* xrow, const float* g, bf16* orow, int lane) {
    const f32x4* xr = (const f32x4*)xrow + lane; f32x4 v[8]; float s = 0.f;
#pragma unroll
    for (int j = 0; j < 8; ++j) { v[j] = xr[64 * j]; s += (v[j].x * v[j].x + v[j].y * v[j].y) + (v[j].z * v[j].z + v[j].w * v[j].w); }
    const float rstd = 1.0f / sqrtf(wave_sum(s) * (1.f / D) + EPS);
    v2u* o8 = (v2u*)orow + lane;
#pragma unroll
    for (int j = 0; j < 8; ++j) { const f32x4 gg = ((const f32x4*)g)[lane + 64 * j]; const f32x4 o = v[j] * rstd * gg; v2u w; w.x = pk2(o.x, o.y); w.y = pk2(o.z, o.w); o8[64 * j] = w; }
}
__device__ __forceinline__ const float* h_row(const Ctx& c, const float* main, int row) {
    return row < MS ? main + (size_t)row * D : (const float*)(c.ws + WS_HMPAD) + (size_t)(row - MS) * D;
}
__device__ __forceinline__ void norm_phase(const Ctx& c, const float* main, const float* g) {
    const int gw = c.bid * 8 + c.wave, NGW = c.G * 8;
    bf16* XN = (bf16*)(c.ws + WS_XN);
    for (int row = gw; row < MP; row += NGW) {
        if (row < MR) rms_row_bf16(h_row(c, main, row), g, XN + (size_t)row * D, c.lane);
        else { v4u z = {0u, 0u, 0u, 0u}; v4u* o = (v4u*)(XN + (size_t)row * D); for (int j = 0; j < 4; ++j) o[c.lane + 64 * j] = z; }
    }
}

__device__ __forceinline__ void ph_pre(const Ctx& c) {
    LAS float* scr = (LAS float*)(c.lds + c.wave * 16640);
    const int gw = c.bid * 8 + c.wave, NGW = c.G * 8;
    {
        int base = 0;
        for (int j = 0; j < 15; ++j) { const TJob t = job_l0(c, j); const int ni = t.nsg * (t.K / 64);
            int first = gw - (base % NGW); if (first < 0) first += NGW;
            for (int it = first; it < ni; it += NGW) run_job_item(t, it, scr, c.lane);
            base += ni; }
    }
    { float* hm = (float*)(c.ws + WS_HMPAD); const float* meta = c.in[I_META];
      for (int i = c.bid * 512 + c.tid; i < 256 * D; i += c.G * 512) hm[i] = i < NMETA * D ? meta[i] : 0.f; }
    { float* rt = (float*)(c.ws + WS_ROPE);
      for (int i = c.bid * 512 + c.tid; i < TT * 16; i += c.G * 512) { const int t = i >> 4, j = i & 15;
          const float fr = (float)exp(-(double)j * (1.0 / 16.0) * 13.122363377404328  );
          const float ang = (float)t * fr; rt[2 * i] = (float)cos((double)ang); rt[2 * i + 1] = (float)sin((double)ang); } }
    { bf16* XN = (bf16*)(c.ws + WS_XN); const float* g = c.in[I_ABNORM];
      for (int row = gw; row < MP; row += NGW) {
          if (row < MS) rms_row_bf16(c.in[I_X] + (size_t)row * D, g, XN + (size_t)row * D, c.lane);
          else if (row < MR) rms_row_bf16(c.in[I_META] + (size_t)(row - MS) * D, g, XN + (size_t)row * D, c.lane);
          else { v4u z = {0u, 0u, 0u, 0u}; v4u* o = (v4u*)(XN + (size_t)row * D); for (int j = 0; j < 4; ++j) o[c.lane + 64 * j] = z; } } }
}
__device__ __forceinline__ void ph_moecvt(const Ctx& c) {
    LAS float* scr = (LAS float*)(c.lds + c.wave * 16640);
    const int gw = c.bid * 8 + c.wave, NGW = c.G * 8;
    for (int it = gw; it < 24 * 3584; it += NGW) { const TJob t = job_moe(c, it / 3584); run_job_item(t, it % 3584, scr, c.lane); }
}

__device__ __forceinline__ void ph_conv(const Ctx& c) {
    const bf16* Z0 = (const bf16*)(c.ws + WS_Z0); bf16* XC = (bf16*)(c.ws + WS_XC);
    const float* cw = c.in[I_CONVW]; const float* cb = c.in[I_CONVB];
    for (int it = c.bid * 512 + c.tid; it < MP * 128; it += c.G * 512) {
        const int row = it >> 7, c8 = (it & 127) * 8;
        float o[8];
        if (row >= MR) { for (int k = 0; k < 8; ++k) o[k] = 0.f; }
        else {
            for (int k = 0; k < 8; ++k) o[k] = cb[c8 + k];
            int t, b; if (row < MS) { b = row >> 14; t = NMETA + (row & (SEQ - 1)); } else { b = 0; t = row - MS; }
#pragma unroll
            for (int j = 0; j < 4; ++j) { const int tp = t - 3 + j; if (tp < 0) continue;
                const v4u xv = *(const v4u*)(Z0 + (size_t)row_of(b, tp) * NABP + c8);
                const unsigned xs[4] = {xv.x, xv.y, xv.z, xv.w};
#pragma unroll
                for (int k = 0; k < 4; ++k) { o[2 * k] += cw[j * 1024 + c8 + 2 * k] * __builtin_bit_cast(float, xs[k] << 16); o[2 * k + 1] += cw[j * 1024 + c8 + 2 * k + 1] * __builtin_bit_cast(float, xs[k] & 0xffff0000u); } }
        }
        v4u w; w.x = pk2(o[0], o[1]); w.y = pk2(o[2], o[3]); w.z = pk2(o[4], o[5]); w.w = pk2(o[6], o[7]);
        *(v4u*)(XC + (size_t)row * 1024 + c8) = w;
    }
}
struct LruCh { float br, bi, sp; int colr; };
__device__ __forceinline__ void lru_step(const bf16* RI, const bf16* XC, const LruCh& k, int row, int ch, float& a, float& u) {
    const float rp = bf2f(RI[(size_t)row * D + k.colr]) + k.br, ip = bf2f(RI[(size_t)row * D + k.colr + 256]) + k.bi, xc = bf2f(XC[(size_t)row * 1024 + ch]);
    const float r = sigmoidf_(rp), ig = sigmoidf_(ip), la = -8.0f * r * k.sp;
    a = __expf(la); u = sqrtf(-expm1f(2.0f * la)) * ig * xc;
}
__device__ __forceinline__ LruCh lru_ch(const Ctx& c, int ch) {
    LruCh k; k.br = c.in[I_BR][ch]; k.bi = c.in[I_BI][ch]; const float lam = c.in[I_LAM][ch];
    k.sp = (lam > 0.f ? 0.f : -lam) + log1pf(expf(-fabsf(lam)));
    k.colr = (ch >> 8) * 512 + (ch & 255); return k;
}
__device__ __forceinline__ void ph_scan_a(const Ctx& c) {
    const bf16* RI = (const bf16*)(c.ws + WS_RI); const bf16* XC = (const bf16*)(c.ws + WS_XC);
    float* SA = (float*)(c.ws + WS_LSUM); float* SH = SA + 129 * 1024;
    for (int it = c.bid * 512 + c.tid; it < 129 * 1024; it += c.G * 512) {
        const int chunk = it >> 10, ch = it & 1023; const LruCh k = lru_ch(c, ch);
        const int r0 = chunk < 128 ? chunk * 256 : MS, nr = chunk < 128 ? 256 : NMETA;
        float h = 0.f, A = 1.f;
        for (int i = 0; i < nr; ++i) { float a, u; lru_step(RI, XC, k, r0 + i, ch, a, u); h = a * h + u; A *= a; }
        SA[it] = A; SH[it] = h;
    }
}
__device__ __forceinline__ void ph_scan_c(const Ctx& c) {
    const bf16* RI = (const bf16*)(c.ws + WS_RI); const bf16* XC = (const bf16*)(c.ws + WS_XC); const bf16* Z0 = (const bf16*)(c.ws + WS_Z0);
    bf16* MIX = (bf16*)(c.ws + WS_MIX);
    const float* SA = (const float*)(c.ws + WS_LSUM); const float* SH = SA + 129 * 1024;
    for (int it = c.bid * 512 + c.tid; it < 129 * 1024; it += c.G * 512) {
        const int chunk = it >> 10, ch = it & 1023; const LruCh k = lru_ch(c, ch);
        const int r0 = chunk < 128 ? chunk * 256 : MS, nr = chunk < 128 ? 256 : NMETA;
        float h = 0.f;
        if (chunk < 128) { const int b = chunk >> 6, j = chunk & 63; h = SH[128 * 1024 + ch];
            for (int jj = 0; jj < j; ++jj) { const int cc = (b * 64 + jj) * 1024 + ch; h = SA[cc] * h + SH[cc]; } }
        for (int i = 0; i < nr; ++i) { const int row = r0 + i; float a, u; lru_step(RI, XC, k, row, ch, a, u); h = a * h + u;
            const float yb = bf2f(Z0[(size_t)row * NABP + 1024 + ch]);
            MIX[(size_t)row * D + ch] = (bf16)f2bf(h * gelu_tanh(yb)); }
    }
}

struct GlaUnit { int row0, ntok, h, su; };
__device__ __forceinline__ GlaUnit gla_unit(int u) {
    GlaUnit g; if (u < 4) { g.row0 = MS; g.ntok = NMETA; g.h = u; g.su = -1; }
    else { const int v = u - 4, b = v >> 10, c1 = (v & 1023) >> 2; g.h = v & 3; g.row0 = b * SEQ + 64 * c1; g.ntok = 64; g.su = v; }
    return g;
}
constexpr int GL_GLR = 0, GL_PART = 4096, GL_BC = 6144, GL_A = 38912;
__device__ __forceinline__ void gla_bcum(const Ctx& c, const GlaUnit& g) {
    const bf16* Z0 = (const bf16*)(c.ws + WS_Z0);
    LAS float* glr = (LAS float*)(c.lds + GL_GLR); LAS float* part = (LAS float*)(c.lds + GL_PART); LAS float* bc = (LAS float*)(c.lds + GL_BC);
    for (int i = c.tid; i < 1024; i += 512) { const int tok = i >> 4, r = i & 15; glr[i] = tok < g.ntok ? bf2f(Z0[(size_t)(g.row0 + tok) * NABP + 5120 + r]) : 0.f; }
    const int dk = c.tid & 127, tg = c.tid >> 7;
    float w[16];
#pragma unroll
    for (int r = 0; r < 16; ++r) w[r] = c.in[I_WGK][r * 512 + g.h * 128 + dk];
    const float bias = c.in[I_BGK][g.h * 128 + dk];
    __syncthreads();
    float run = 0.f;
#pragma unroll 2
    for (int i = 0; i < 16; ++i) { const int tok = 16 * tg + i; float x = bias;
#pragma unroll
        for (int r = 0; r < 16; ++r) x += glr[tok * 16 + r] * w[r];
        const float ls = fminf(x, 0.f) - log1pf(__expf(-fabsf(x)));
        run += tok < g.ntok ? ls * (1.0f / 16.0f) : 0.f; bc[tok * 128 + dk] = run; }
    part[tg * 128 + dk] = run;
    __syncthreads();
    float off = 0.f; for (int t2 = 0; t2 < tg; ++t2) off += part[t2 * 128 + dk];
#pragma unroll 4
    for (int i = 0; i < 16; ++i) bc[(16 * tg + i) * 128 + dk] += off;
    __syncthreads();
}
__device__ __forceinline__ void gla_load_vt(const Ctx& c, const GlaUnit& g, LAS bf16* VT) {
    const bf16* Z0 = (const bf16*)(c.ws + WS_Z0);
    const int dv = c.tid & 255, th = c.tid >> 8;
#pragma unroll 8
    for (int i = 0; i < 32; ++i) { const int tok = 32 * th + i; VT[dv * 72 + tok] = tok < g.ntok ? Z0[(size_t)(g.row0 + tok) * NABP + 3072 + g.h * 256 + dv] : (bf16)0; }
}
__device__ __forceinline__ void ph_gla1(const Ctx& c) {
    const bf16* Z0 = (const bf16*)(c.ws + WS_Z0);
    LAS float* bc = (LAS float*)(c.lds + GL_BC);
    LAS bf16* KrT = (LAS bf16*)(c.lds + GL_A); LAS bf16* VT = (LAS bf16*)(c.lds + GL_A + 18432);
    float* DST = (float*)(c.ws + WS_DST); float* DEC = (float*)(c.ws + WS_DEC);
    const int lane = c.lane, g4 = lane >> 4, l15 = lane & 15;
    for (int u = c.bid; u < GLA_UNITS; u += c.G) {
        const GlaUnit g = gla_unit(u);
        gla_bcum(c, g);
        { const int dk = c.tid & 127, tg = c.tid >> 7; const float bl = bc[63 * 128 + dk];
          if (tg == 0) DEC[(size_t)u * 128 + dk] = __expf(bl);
#pragma unroll 4
          for (int i = 0; i < 16; ++i) { const int tok = 16 * tg + i;
              const float kv = tok < g.ntok ? bf2f(Z0[(size_t)(g.row0 + tok) * NABP + 2560 + g.h * 128 + dk]) : 0.f;
              KrT[dk * 72 + tok] = (bf16)f2bf(kv * __expf(bl - bc[tok * 128 + dk])); } }
        gla_load_vt(c, g, VT);
        __syncthreads();
        f32x4 acc[2][8];
#pragma unroll
        for (int a = 0; a < 2; ++a)
#pragma unroll
            for (int b = 0; b < 8; ++b) acc[a][b] = (f32x4){0.f, 0.f, 0.f, 0.f};
#pragma unroll
        for (int ks = 0; ks < 2; ++ks) {
            bf16x8 af[2], bfr[8];
#pragma unroll
            for (int a = 0; a < 2; ++a) af[a] = *(const LAS bf16x8*)(VT + ((2 * c.wave + a) * 16 + l15) * 72 + ks * 32 + 8 * g4);
#pragma unroll
            for (int b = 0; b < 8; ++b) bfr[b] = *(const LAS bf16x8*)(KrT + (b * 16 + l15) * 72 + ks * 32 + 8 * g4);
#pragma unroll
            for (int a = 0; a < 2; ++a)
#pragma unroll
                for (int b = 0; b < 8; ++b) acc[a][b] = __builtin_amdgcn_mfma_f32_16x16x32_bf16(af[a], bfr[b], acc[a][b], 0, 0, 0);
        }
        float* dst = DST + (size_t)u * 32768;
#pragma unroll
        for (int a = 0; a < 2; ++a)
#pragma unroll
            for (int b = 0; b < 8; ++b)
#pragma unroll
                for (int j = 0; j < 4; ++j) dst[((2 * c.wave + a) * 16 + 4 * g4 + j) * 128 + b * 16 + l15] = acc[a][b][j];
        __syncthreads();
    }
}
__device__ __forceinline__ void ph_gla2(const Ctx& c) {
    const float* DST = (const float*)(c.ws + WS_DST); const float* DEC = (const float*)(c.ws + WS_DEC); bf16* ST = (bf16*)(c.ws + WS_ST);
    const int gw = c.bid * 8 + c.wave, NGW = c.G * 8;
    for (int it = gw; it < 2048; it += NGW) {
        const int b = it >> 10, h = (it >> 8) & 3, dv = it & 255;
        f32x2 S = *(const f32x2*)(DST + (size_t)h * 32768 + dv * 128 + 2 * c.lane);
        for (int c0 = 0; c0 < 256; c0 += 8) {
            f32x2 ds[8], de[8];
#pragma unroll
            for (int k = 0; k < 8; ++k) { const size_t u = 4 + (size_t)b * 1024 + (size_t)(c0 + k) * 4 + h;
                ds[k] = *(const f32x2*)(DST + u * 32768 + dv * 128 + 2 * c.lane); de[k] = *(const f32x2*)(DEC + u * 128 + 2 * c.lane); }
#pragma unroll
            for (int k = 0; k < 8; ++k) { const size_t su = (size_t)b * 1024 + (size_t)(c0 + k) * 4 + h;
                *(unsigned*)(ST + su * 32768 + dv * 128 + 2 * c.lane) = pk2(S.x, S.y);
                S = de[k] * S + ds[k]; }
        }
    }
}
__device__ __forceinline__ void ph_gla3(const Ctx& c) {
    const bf16* Z0 = (const bf16*)(c.ws + WS_Z0); const bf16* ST = (const bf16*)(c.ws + WS_ST); bf16* MIX = (bf16*)(c.ws + WS_MIX);
    LAS float* bc = (LAS float*)(c.lds + GL_BC);
    LAS bf16* Qd = (LAS bf16*)(c.lds + GL_A); LAS bf16* Kd = (LAS bf16*)(c.lds + GL_A + 17408); LAS bf16* VT = (LAS bf16*)(c.lds + GL_A + 34816);
    LAS bf16* att = (LAS bf16*)(c.lds + GL_A + 71680); LAS float* ssq = (LAS float*)(c.lds + GL_A + 80896); LAS float* rst = (LAS float*)(c.lds + GL_A + 82944);
    const int lane = c.lane, g4 = lane >> 4, l15 = lane & 15, w = c.wave;
    for (int u = c.bid; u < GLA_UNITS; u += c.G) {
        const GlaUnit g = gla_unit(u);
        gla_bcum(c, g);
        { const int dk = c.tid & 127, tg = c.tid >> 7;
#pragma unroll 4
          for (int i = 0; i < 16; ++i) { const int tok = 16 * tg + i; const bool ok = tok < g.ntok; const size_t ro = (size_t)(g.row0 + tok) * NABP + g.h * 128 + dk;
              const float qv = ok ? bf2f(Z0[ro + 2048]) : 0.f, kv = ok ? bf2f(Z0[ro + 2560]) : 0.f, bb = bc[tok * 128 + dk];
              Qd[tok * 136 + dk] = (bf16)f2bf(qv * __expf(bb) * 0.08838834764831845f); Kd[tok * 136 + dk] = (bf16)f2bf(kv * __expf(-bb)); } }
        gla_load_vt(c, g, VT);
        __syncthreads();
        {
            const int ti = w >> 1;
#pragma unroll
            for (int q = 0; q < 2; ++q) { const int sj = 2 * (w & 1) + q; f32x4 a = (f32x4){0.f, 0.f, 0.f, 0.f};
                if (sj <= ti) {
#pragma unroll
                    for (int ks = 0; ks < 4; ++ks) { const bf16x8 af = *(const LAS bf16x8*)(Qd + (ti * 16 + l15) * 136 + ks * 32 + 8 * g4);
                        const bf16x8 bfr = *(const LAS bf16x8*)(Kd + (sj * 16 + l15) * 136 + ks * 32 + 8 * g4);
                        a = __builtin_amdgcn_mfma_f32_16x16x32_bf16(af, bfr, a, 0, 0, 0); } }
#pragma unroll
                for (int j = 0; j < 4; ++j) { const int t = ti * 16 + 4 * g4 + j, s = sj * 16 + l15; att[t * 72 + s] = (bf16)f2bf(s <= t ? a[j] : 0.f); } }
        }
        __syncthreads();
        f32x4 acc[4][2];
#pragma unroll
        for (int ti = 0; ti < 4; ++ti)
#pragma unroll
            for (int n = 0; n < 2; ++n) acc[ti][n] = (f32x4){0.f, 0.f, 0.f, 0.f};
        if (g.su >= 0) {
            const bf16* st = ST + (size_t)g.su * 32768;
#pragma unroll
            for (int ks = 0; ks < 4; ++ks) { bf16x8 bfr[2];
#pragma unroll
                for (int n = 0; n < 2; ++n) bfr[n] = *(const bf16x8*)(st + (size_t)(32 * w + 16 * n + l15) * 128 + ks * 32 + 8 * g4);
#pragma unroll
                for (int ti = 0; ti < 4; ++ti) { const bf16x8 af = *(const LAS bf16x8*)(Qd + (ti * 16 + l15) * 136 + ks * 32 + 8 * g4);
#pragma unroll
                    for (int n = 0; n < 2; ++n) acc[ti][n] = __builtin_amdgcn_mfma_f32_16x16x32_bf16(af, bfr[n], acc[ti][n], 0, 0, 0); } }
        }
#pragma unroll
        for (int ks = 0; ks < 2; ++ks) { bf16x8 bfr[2];
#pragma unroll
            for (int n = 0; n < 2; ++n) bfr[n] = *(const LAS bf16x8*)(VT + (32 * w + 16 * n + l15) * 72 + ks * 32 + 8 * g4);
#pragma unroll
            for (int ti = 0; ti < 4; ++ti) { const bf16x8 af = *(const LAS bf16x8*)(att + (ti * 16 + l15) * 72 + ks * 32 + 8 * g4);
#pragma unroll
                for (int n = 0; n < 2; ++n) acc[ti][n] = __builtin_amdgcn_mfma_f32_16x16x32_bf16(af, bfr[n], acc[ti][n], 0, 0, 0); } }
#pragma unroll
        for (int ti = 0; ti < 4; ++ti)
#pragma unroll
            for (int j = 0; j < 4; ++j) { float p = acc[ti][0][j] * acc[ti][0][j] + acc[ti][1][j] * acc[ti][1][j];
                p += __shfl_xor(p, 1); p += __shfl_xor(p, 2); p += __shfl_xor(p, 4); p += __shfl_xor(p, 8);
                if (l15 == 0) ssq[w * 64 + ti * 16 + 4 * g4 + j] = p; }
        __syncthreads();
        if (c.tid < 64) { float s = 0.f; for (int k = 0; k < 8; ++k) s += ssq[k * 64 + c.tid]; rst[c.tid] = 1.0f / sqrtf(s * (1.f / 256.f) + EPS); }
        __syncthreads();
#pragma unroll
        for (int ti = 0; ti < 4; ++ti)
#pragma unroll
            for (int j = 0; j < 4; ++j) { const int t = ti * 16 + 4 * g4 + j;
                if (t < g.ntok) { const float rs = rst[t]; const size_t row = (size_t)(g.row0 + t);
#pragma unroll
                    for (int n = 0; n < 2; ++n) { const int e = 32 * w + 16 * n + l15;
                        const float gate = bf2f(Z0[row * NABP + 4096 + g.h * 256 + e]);
                        MIX[row * D + 1024 + g.h * 256 + e] = (bf16)f2bf(acc[ti][n][j] * rs * c.in[I_GLANORM][e] * siluf_(gate)); } } }
        __syncthreads();
    }
}

__device__ __forceinline__ void rope_pair(bf16* p, int d, float cs, float sn) {
    const float x1 = bf2f(p[0]), x2 = bf2f(p[d]); p[0] = (bf16)f2bf(x1 * cs - x2 * sn); p[d] = (bf16)f2bf(x2 * cs + x1 * sn);
}
__device__ __forceinline__ void ph_rope(const Ctx& c) {
    bf16* Z1 = (bf16*)(c.ws + WS_Z1); bf16* KIP = (bf16*)(c.ws + WS_KIP); float* WIS = (float*)(c.ws + WS_WIS); const float* rt = (const float*)(c.ws + WS_ROPE);
    const int gw = c.bid * 8 + c.wave, NGW = c.G * 8, lane = c.lane;
    for (int row = gw; row < MR; row += NGW) {
        const int t = row < MS ? NMETA + (row & (SEQ - 1)) : row - MS;
        bf16* z = Z1 + (size_t)row * NCP;
        const float* r = rt + (size_t)t * 32;
        for (int p = lane; p < 320; p += 64) { const int hd = p >> 4, j = p & 15; rope_pair(z + hd * 128 + j, 16, r[2 * j], r[2 * j + 1]); }
        for (int p = lane; p < 72; p += 64) { const int hd = p >> 3, j = p & 7; rope_pair(z + 3072 + hd * 64 + j, 8, r[4 * j], r[4 * j + 1]); }
        LDS_WAIT(); VM_WAIT();
        asm volatile("" ::: "memory");
        const unsigned kv = *(const unsigned*)(z + 3584 + 2 * (lane & 31));
        if (row < MS) { if (lane < 32) *(unsigned*)(KIP + ((size_t)(row >> 14) * (TT + 16) + t) * 64 + 2 * lane) = kv; }
        else *(unsigned*)(KIP + ((size_t)(lane >> 5) * (TT + 16) + t) * 64 + 2 * (lane & 31)) = kv;
        if (lane < 8) WIS[(size_t)row * 8 + lane] = bf2f(z[3648 + lane]) * 0.04419417382415922f;
    }
}
constexpr int IX_CAP = 512, IX_KEEP = 240;
__device__ __forceinline__ unsigned ix_pack(float s, int key) {
    const unsigned u = __builtin_bit_cast(unsigned, s); const unsigned k = (u & 0x80000000u) ? ~u : (u | 0x80000000u);
    return (k & 0xFFFF8000u) | (unsigned)(32767 - key);
}
__device__ __forceinline__ float ix_thr(unsigned v) {
    const unsigned k = v & 0xFFFF8000u; const unsigned u = (k & 0x80000000u) ? (k ^ 0x80000000u) : ~k; return __builtin_bit_cast(float, u);
}
__device__ __forceinline__ void ix_compact(LAS unsigned* buf, LAS unsigned* cnt, LAS float* tau, int q, int lane) {
    LDS_WAIT();
    const int n = (int)cnt[q];
    if (n <= IX_KEEP) return;
    unsigned e[8];
#pragma unroll
    for (int i = 0; i < 8; ++i) e[i] = (lane + 64 * i < n) ? buf[q * IX_CAP + lane + 64 * i] : 0u;
    unsigned v = 0u;
    for (int bit = 31; bit >= 0; --bit) { const unsigned cand = v | (1u << bit); int cc = 0;
#pragma unroll
        for (int i = 0; i < 8; ++i) cc += __builtin_popcountll(__ballot(e[i] >= cand));
        if (cc >= IX_KEEP) v = cand; }
    int base = 0;
#pragma unroll
    for (int i = 0; i < 8; ++i) { const bool keep = e[i] >= v; const unsigned long long m = __ballot(keep);
        const int pos = base + (int)__builtin_amdgcn_mbcnt_hi((unsigned)(m >> 32), __builtin_amdgcn_mbcnt_lo((unsigned)m, 0u));
        if (keep) buf[q * IX_CAP + pos] = e[i]; base += __builtin_popcountll(m); }
    if (lane == 0) { cnt[q] = (unsigned)IX_KEEP; tau[q] = ix_thr(v); }
    LDS_WAIT();
}
__device__ __forceinline__ void ix_task(const Ctx& c, int b, int grp) {
    const bf16* Z1 = (const bf16*)(c.ws + WS_Z1); const bf16* KIP = (const bf16*)(c.ws + WS_KIP) + (size_t)b * (TT + 16) * 64; const float* WIS = (const float*)(c.ws + WS_WIS);
    unsigned short* SEL = (unsigned short*)(c.ws + WS_SEL); int* SELCNT = (int*)(c.ws + WS_SELCNT);
    LAS unsigned* buf = (LAS unsigned*)c.lds; LAS unsigned* cnt = (LAS unsigned*)(c.lds + 131072); LAS float* tau = (LAS float*)(c.lds + 131072 + 256);
    const int lane = c.lane, g4 = lane >> 4, l15 = lane & 15, qs = c.wave * 8;
    const int t0 = NMETA + 8 * grp;
    const int qrow0 = b * SEQ + 8 * grp;
    if (lane < 8) { cnt[qs + lane] = 0u; tau[qs + lane] = -__builtin_inff(); }
    bf16x8 af[2][2][2]; float wq[2][8];
#pragma unroll
    for (int qg = 0; qg < 2; ++qg) { const size_t ro = (size_t)(qrow0 + 4 * qg + (l15 >> 2)) * NCP + 3072;
#pragma unroll
        for (int hh = 0; hh < 2; ++hh)
#pragma unroll
            for (int ks = 0; ks < 2; ++ks) af[qg][hh][ks] = *(const bf16x8*)(Z1 + ro + (4 * hh + (l15 & 3)) * 64 + 32 * ks + 8 * g4);
        const float* wp = WIS + (size_t)(qrow0 + 4 * qg + g4) * 8;
#pragma unroll
        for (int h = 0; h < 8; ++h) wq[qg][h] = wp[h]; }
    float th[2] = {-__builtin_inff(), -__builtin_inff()};
    LDS_WAIT();
    for (int kb = NMETA; kb <= t0 + 7; kb += 16) {
        bf16x8 bk[2];
#pragma unroll
        for (int ks = 0; ks < 2; ++ks) bk[ks] = *(const bf16x8*)(KIP + (size_t)(kb + l15) * 64 + 32 * ks + 8 * g4);
        const int key = kb + l15; bool flag = false;
#pragma unroll
        for (int qg = 0; qg < 2; ++qg) {
            f32x4 d0 = (f32x4){0.f, 0.f, 0.f, 0.f}, d1 = d0;
#pragma unroll
            for (int ks = 0; ks < 2; ++ks) { d0 = __builtin_amdgcn_mfma_f32_16x16x32_bf16(af[qg][0][ks], bk[ks], d0, 0, 0, 0); d1 = __builtin_amdgcn_mfma_f32_16x16x32_bf16(af[qg][1][ks], bk[ks], d1, 0, 0, 0); }
            float s = 0.f;
#pragma unroll
            for (int j = 0; j < 4; ++j) { s += wq[qg][j] * fmaxf(d0[j], 0.f); s += wq[qg][4 + j] * fmaxf(d1[j], 0.f); }
            const bool pass = (key <= t0 + 4 * qg + g4) && (s > th[qg]);
            if (pass) { const int q = qs + 4 * qg + g4;
                const unsigned slot = __hip_atomic_fetch_add(cnt + q, 1u, __ATOMIC_RELAXED, __HIP_MEMORY_SCOPE_WORKGROUP);
                buf[q * IX_CAP + slot] = ix_pack(s, key); flag |= (slot + 1u >= (unsigned)(IX_CAP - 16)); }
        }
        if (__any(flag)) {
            for (int i = 0; i < 8; ++i) { LDS_WAIT(); if ((int)cnt[qs + i] >= IX_CAP - 16) ix_compact(buf, cnt, tau, qs + i, lane); }
            LDS_WAIT();
            th[0] = tau[qs + g4]; th[1] = tau[qs + 4 + g4];
        }
    }
    for (int i = 0; i < 8; ++i) {
        ix_compact(buf, cnt, tau, qs + i, lane);
        LDS_WAIT();
        const int n = (int)cnt[qs + i];
        for (int j = lane; j < n; j += 64) SEL[(size_t)(qrow0 + i) * IX_KEEP + j] = (unsigned short)(32767u - (buf[(qs + i) * IX_CAP + j] & 0x7FFFu));
        if (lane == 0) SELCNT[qrow0 + i] = n;
    }
    LDS_WAIT();
}
__device__ __forceinline__ void ph_index(const Ctx& c) {
    const int gw = c.bid * 8 + c.wave, NGW = c.G * 8;
    for (int p = gw; p < 2048; p += NGW) { ix_task(c, 0, 2047 - p); ix_task(c, 1, p); }
}
__device__ __forceinline__ void ph_attn(const Ctx& c) {
    const bf16* Z1 = (const bf16*)(c.ws + WS_Z1); const unsigned short* SEL = (const unsigned short*)(c.ws + WS_SEL); const int* SELCNT = (const int*)(c.ws + WS_SELCNT);
    bf16* ATT = (bf16*)(c.ws + WS_ATT);
    LAS int* rows = (LAS int*)(c.lds + c.wave * 5120); LAS float* P = (LAS float*)(c.lds + c.wave * 5120 + 1024);
    const int lane = c.lane, g4 = lane >> 4, l15 = lane & 15;
    const int cls = c.bid & 7, b = cls >> 2, g = cls & 3;
    const int rank = (c.bid >> 3) * 8 + c.wave, nrank = (c.G >> 3) * 8;
    for (int t = rank; t < TT; t += nrank) {
        if (b == 1 && t < NMETA) continue;
        const int qrow = row_of(b, t);
        int n;
        if (t < NMETA) { n = t + 1; for (int j = lane; j < 256; j += 64) rows[j] = MS + (j < n ? j : 0); }
        else { const int cn = SELCNT[qrow]; n = NMETA + cn;
            for (int j = lane; j < 256; j += 64) { int r = MS; if (j < NMETA) r = MS + j; else if (j < n) r = b * SEQ + (int)SEL[(size_t)qrow * IX_KEEP + (j - NMETA)] - NMETA; rows[j] = r; } }
        bf16x8 qf[4];
#pragma unroll
        for (int ks = 0; ks < 4; ++ks) { qf[ks] = (bf16x8){0, 0, 0, 0, 0, 0, 0, 0}; if (l15 < 4) qf[ks] = *(const bf16x8*)(Z1 + (size_t)qrow * NCP + (4 * g + l15) * 128 + 32 * ks + 8 * g4); }
        LDS_WAIT();
        const int ntile = (n + 15) >> 4;
        f32x4 S[16];
#pragma unroll
        for (int tl = 0; tl < 16; ++tl) { S[tl] = (f32x4){0.f, 0.f, 0.f, 0.f};
            if (tl < ntile) { const int krow = rows[tl * 16 + l15]; const bf16* kp = Z1 + (size_t)krow * NCP + 2048 + g * 128 + 8 * g4;
#pragma unroll
                for (int ks = 0; ks < 4; ++ks) { const bf16x8 kf = *(const bf16x8*)(kp + 32 * ks); S[tl] = __builtin_amdgcn_mfma_f32_16x16x32_bf16(kf, qf[ks], S[tl], 0, 0, 0); } } }
        float mx = -__builtin_inff();
#pragma unroll
        for (int tl = 0; tl < 16; ++tl)
#pragma unroll
            for (int j = 0; j < 4; ++j) { const int kk = tl * 16 + 4 * g4 + j; const float s = kk < n ? S[tl][j] * 0.08838834764831845f : -__builtin_inff(); S[tl][j] = s; mx = fmaxf(mx, s); }
        mx = fmaxf(mx, __shfl_xor(mx, 16)); mx = fmaxf(mx, __shfl_xor(mx, 32));
        float sum = 0.f;
#pragma unroll
        for (int tl = 0; tl < 16; ++tl)
#pragma unroll
            for (int j = 0; j < 4; ++j) { const float e = __expf(S[tl][j] - mx); S[tl][j] = e; sum += e; }
        sum += __shfl_xor(sum, 16); sum += __shfl_xor(sum, 32);
        const float inv = 1.0f / sum;
        if (l15 < 4) {
#pragma unroll
            for (int tl = 0; tl < 16; ++tl)
#pragma unroll
                for (int j = 0; j < 4; ++j) P[(tl * 16 + 4 * g4 + j) * 4 + l15] = S[tl][j] * inv; }
        LDS_WAIT();
        float acc[4][8];
#pragma unroll
        for (int h = 0; h < 4; ++h)
#pragma unroll
            for (int d = 0; d < 8; ++d) acc[h][d] = 0.f;
        for (int it = 0; it < ntile * 4; ++it) { const int kk = 4 * it + g4; const int r = rows[kk];
            const v4u vv = *(const v4u*)(Z1 + (size_t)r * NCP + 2560 + g * 128 + 8 * l15); const f32x4 p4 = *(const LAS f32x4*)(P + kk * 4);
            const unsigned vs[4] = {vv.x, vv.y, vv.z, vv.w};
#pragma unroll
            for (int k = 0; k < 4; ++k) { const float v0 = __builtin_bit_cast(float, vs[k] << 16), v1 = __builtin_bit_cast(float, vs[k] & 0xffff0000u);
#pragma unroll
                for (int h = 0; h < 4; ++h) { acc[h][2 * k] += p4[h] * v0; acc[h][2 * k + 1] += p4[h] * v1; } } }
#pragma unroll
        for (int h = 0; h < 4; ++h)
#pragma unroll
            for (int d = 0; d < 8; ++d) { float v = acc[h][d]; v += __shfl_xor(v, 16); v += __shfl_xor(v, 32); acc[h][d] = v; }
        if (lane < 16) {
#pragma unroll
            for (int h = 0; h < 4; ++h) { v4u w; w.x = pk2(acc[h][0], acc[h][1]); w.y = pk2(acc[h][2], acc[h][3]); w.z = pk2(acc[h][4], acc[h][5]); w.w = pk2(acc[h][6], acc[h][7]);
                *(v4u*)(ATT + (size_t)qrow * D + (4 * g + h) * 128 + 8 * lane) = w; } }
        LDS_WAIT();
    }
}

__device__ __forceinline__ void ph_r1(const Ctx& c) {
    LAS unsigned* lcnt = (LAS unsigned*)c.lds;
    if (c.tid < 8) lcnt[c.tid] = 0u;
    __syncthreads();
    bf16* XN = (bf16*)(c.ws + WS_XN); const float* g = c.in[I_MOENORM]; const float* wr = c.in[I_ROUTER];
    int* TOPI = (int*)(c.ws + WS_TOP); float* TOPG = (float*)(c.ws + WS_TOP) + 65536;
    const int gw = c.bid * 8 + c.wave, NGW = c.G * 8, lane = c.lane;
    for (int row = gw; row < MS; row += NGW) {
        const f32x4* xr = (const f32x4*)(c.out + (size_t)row * D) + lane; f32x4 v[8]; float s = 0.f;
#pragma unroll
        for (int j = 0; j < 8; ++j) { v[j] = xr[64 * j]; s += (v[j].x * v[j].x + v[j].y * v[j].y) + (v[j].z * v[j].z + v[j].w * v[j].w); }
        const float rstd = 1.0f / sqrtf(wave_sum(s) * (1.f / D) + EPS);
        float lg[8];
#pragma unroll
        for (int e = 0; e < 8; ++e) lg[e] = 0.f;
        v2u* o8 = (v2u*)(XN + (size_t)row * D) + lane;
#pragma unroll
        for (int j = 0; j < 8; ++j) { const f32x4 gg = ((const f32x4*)g)[lane + 64 * j]; const f32x4 o = v[j] * rstd * gg; v2u w; w.x = pk2(o.x, o.y); w.y = pk2(o.z, o.w); o8[64 * j] = w;
            const float* wp = wr + (size_t)(4 * (lane + 64 * j)) * 8;
#pragma unroll
            for (int k = 0; k < 4; ++k) { const f32x4 w0 = *(const f32x4*)(wp + 8 * k), w1 = *(const f32x4*)(wp + 8 * k + 4);
                lg[0] += o[k] * w0.x; lg[1] += o[k] * w0.y; lg[2] += o[k] * w0.z; lg[3] += o[k] * w0.w; lg[4] += o[k] * w1.x; lg[5] += o[k] * w1.y; lg[6] += o[k] * w1.z; lg[7] += o[k] * w1.w; } }
#pragma unroll
        for (int e = 0; e < 8; ++e) lg[e] = wave_sum(lg[e]);
        int i0 = 0; float v0 = lg[0];
#pragma unroll
        for (int e = 1; e < 8; ++e) if (lg[e] > v0) { v0 = lg[e]; i0 = e; }
        int i1 = -1; float v1 = -__builtin_inff();
#pragma unroll
        for (int e = 0; e < 8; ++e) if (e != i0 && lg[e] > v1) { v1 = lg[e]; i1 = e; }
        if (lane == 0) { const float e1 = __expf(v1 - v0), g0 = 1.0f / (1.0f + e1);
            TOPI[2 * row] = i0; TOPI[2 * row + 1] = i1; TOPG[2 * row] = g0; TOPG[2 * row + 1] = e1 * g0;
            __hip_atomic_fetch_add(lcnt + i0, 1u, __ATOMIC_RELAXED, __HIP_MEMORY_SCOPE_WORKGROUP); __hip_atomic_fetch_add(lcnt + i1, 1u, __ATOMIC_RELAXED, __HIP_MEMORY_SCOPE_WORKGROUP); }
    }
    __syncthreads();
    if (c.tid < 8) ((unsigned*)(c.ws + WS_MOET))[MT_BLKCNT + c.bid * 8 + c.tid] = lcnt[c.tid];
}
__device__ __forceinline__ void ph_r2(const Ctx& c) {
    LAS unsigned* cur = (LAS unsigned*)c.lds;
    unsigned* MT = (unsigned*)(c.ws + WS_MOET);
    LAS unsigned* tot = cur + 8; LAS unsigned* mine = cur + 16;
    if (c.tid < 24) cur[c.tid] = 0u;
    __syncthreads();
    for (int idx = c.tid; idx < c.G * 8; idx += 512) { const unsigned v = ld_agent(MT + MT_BLKCNT + idx); const int bl = idx >> 3, e = idx & 7;
        __hip_atomic_fetch_add(tot + e, v, __ATOMIC_RELAXED, __HIP_MEMORY_SCOPE_WORKGROUP); if (bl < c.bid) __hip_atomic_fetch_add(mine + e, v, __ATOMIC_RELAXED, __HIP_MEMORY_SCOPE_WORKGROUP); }
    __syncthreads();
    if (c.tid < 8) { unsigned start = 0u; for (int e = 0; e < c.tid; ++e) start += ((tot[e] + 255u) >> 8) << 8;
        cur[c.tid] = start + mine[c.tid];
        if (c.bid == 0) { const unsigned nt_e = (tot[c.tid] + 255u) >> 8, t0 = start >> 8; for (unsigned k = 0; k < nt_e; ++k) MT[MT_TILEEXP + t0 + k] = (unsigned)c.tid;
            if (c.tid == 7) MT[MT_NTILES] = t0 + nt_e; } }
    __syncthreads();
    const bf16* XN = (const bf16*)(c.ws + WS_XN); bf16* XG = (bf16*)(c.ws + WS_XG);
    const int* TOPI = (const int*)(c.ws + WS_TOP); int* POS = (int*)(c.ws + WS_TOP) + 131072;
    const int gw = c.bid * 8 + c.wave, NGW = c.G * 8, lane = c.lane;
    for (int row = gw; row < MS; row += NGW) {
        int p0 = 0, p1 = 0;
        if (lane == 0) { p0 = (int)__hip_atomic_fetch_add(cur + TOPI[2 * row], 1u, __ATOMIC_RELAXED, __HIP_MEMORY_SCOPE_WORKGROUP); p1 = (int)__hip_atomic_fetch_add(cur + TOPI[2 * row + 1], 1u, __ATOMIC_RELAXED, __HIP_MEMORY_SCOPE_WORKGROUP);
            POS[2 * row] = p0; POS[2 * row + 1] = p1; }
        p0 = __shfl(p0, 0); p1 = __shfl(p1, 0);
        const v4u* src = (const v4u*)(XN + (size_t)row * D); v4u* d0 = (v4u*)(XG + (size_t)p0 * D); v4u* d1 = (v4u*)(XG + (size_t)p1 * D);
#pragma unroll
        for (int j = 0; j < 4; ++j) { const v4u v = src[lane + 64 * j]; d0[lane + 64 * j] = v; d1[lane + 64 * j] = v; }
    }
}
__device__ __forceinline__ void ph_final(const Ctx& c) {
    const bf16* Y = (const bf16*)(c.ws + WS_Y); const float* TOPG = (const float*)(c.ws + WS_TOP) + 65536; const int* POS = (const int*)(c.ws + WS_TOP) + 131072;
    const float* g = c.in[I_FINALNORM];
    const int gw = c.bid * 8 + c.wave, NGW = c.G * 8, lane = c.lane;
    for (int row = gw; row < MS; row += NGW) {
        const float g0 = TOPG[2 * row], g1 = TOPG[2 * row + 1];
        const v2u* y0 = (const v2u*)(Y + (size_t)POS[2 * row] * D) + lane; const v2u* y1 = (const v2u*)(Y + (size_t)POS[2 * row + 1] * D) + lane;
        f32x4* xr = (f32x4*)(c.out + (size_t)row * D) + lane; f32x4 v[8]; float s = 0.f;
#pragma unroll
        for (int j = 0; j < 8; ++j) { const v2u a = y0[64 * j], bq = y1[64 * j];
            f32x4 ya, yb;
            ya.x = __builtin_bit_cast(float, a.x << 16); ya.y = __builtin_bit_cast(float, a.x & 0xffff0000u); ya.z = __builtin_bit_cast(float, a.y << 16); ya.w = __builtin_bit_cast(float, a.y & 0xffff0000u);
            yb.x = __builtin_bit_cast(float, bq.x << 16); yb.y = __builtin_bit_cast(float, bq.x & 0xffff0000u); yb.z = __builtin_bit_cast(float, bq.y << 16); yb.w = __builtin_bit_cast(float, bq.y & 0xffff0000u);
            v[j] = xr[64 * j] + g0 * ya + g1 * yb; s += (v[j].x * v[j].x + v[j].y * v[j].y) + (v[j].z * v[j].z + v[j].w * v[j].w); }
        const float rstd = 1.0f / sqrtf(wave_sum(s) * (1.f / D) + EPS);
#pragma unroll
        for (int j = 0; j < 8; ++j) { const f32x4 gg = ((const f32x4*)g)[lane + 64 * j]; xr[64 * j] = v[j] * rstd * gg; }
    }
}

enum { PH_PRE = 0, PH_G1, PH_CONV, PH_G2, PH_SCANA, PH_SCANC, PH_GLA3, PH_G3, PH_NORM1, PH_G4, PH_G5, PH_NORM2, PH_G6, PH_ROPE, PH_INDEX, PH_ATTN, PH_G7,
       PH_R1, PH_R2, PH_M0A, PH_M0B, PH_M1A, PH_M1B, PH_M2A, PH_M2B, PH_FINAL, NPH };

__global__ void __launch_bounds__(512, 2) mega(Args args) {
    extern __shared__ __attribute__((aligned(16))) unsigned char lds_raw[];
    Ctx c; c.in = args.in; c.out = args.out; c.ws = args.ws; c.lds = (LAS unsigned char*)lds_raw;
    c.tid = threadIdx.x; c.lane = c.tid & 63; c.wave = __builtin_amdgcn_readfirstlane(c.tid >> 6); c.G = gridDim.x; c.bid = blockIdx.x;
    volatile LAS unsigned* misc = (volatile LAS unsigned*)(c.lds + LDS_MISC);
    if (c.tid < 64) misc[c.tid] = 0u;
    __syncthreads();
    const int lo = args.ph_lo, hi = args.ph_hi;
    XcdBarrier bar; bar.bar = (unsigned*)(c.ws + WS_CTL) + CW_BAR; bar.x = 0; bar.st = misc + 8;
    if (hi - lo > 1) bar = xcd_barrier_post((unsigned*)(c.ws + WS_CTL) + CW_BAR, misc + 8);
#ifndef PH_ENABLE
#define PH_ENABLE 0xFFFFFFFFull
#endif
#define IN(k) ((((PH_ENABLE) >> (k)) & 1ull) && lo <= (k) && (k) < hi)
#define SEAM(k) do { if (IN(k) && IN((k) + 1)) xcd_barrier(bar); else __syncthreads(); } while (0)
    unsigned char* ws = c.ws;
    bf16* XN = (bf16*)(ws + WS_XN); float* HMPAD = (float*)(ws + WS_HMPAD);

    if (IN(PH_PRE)) { ph_pre(c); SEAM(PH_PRE); }
    if (IN(PH_G1)) {
        gm::DenseSched S{129, NABP / 256, c.G, c.bid, (const char*)XN, (const char*)(ws + WS_WINAB), D * 2, D * 2, 0};
        gm::EpiBf16 E{(bf16*)(ws + WS_Z0), NABP, 0};
        gm::gemm_phase(c.lds, S, E, D / 64, D * 2, D * 2); SEAM(PH_G1); }
    if (IN(PH_CONV)) { ph_conv(c); SEAM(PH_CONV); }
    if (IN(PH_G2)) {
        gm::DenseSched S{129, 8, c.G, c.bid, (const char*)(ws + WS_XC), (const char*)(ws + WS_WRI), 1024 * 2, 256 * 2, 1};
        gm::EpiBf16 E{(bf16*)(ws + WS_RI), D, 0};
        gm::gemm_phase(c.lds, S, E, 4, 1024 * 2, 256 * 2); SEAM(PH_G2); }
    if (IN(PH_SCANA)) {
#ifndef NO_SCANA
        ph_scan_a(c);
#endif
#ifndef NO_GLA1
        ph_gla1(c);
#endif
        SEAM(PH_SCANA); }
    if (IN(PH_SCANC)) { ph_scan_c(c); ph_gla2(c); SEAM(PH_SCANC); }
    if (IN(PH_GLA3)) { ph_gla3(c); SEAM(PH_GLA3); }
    if (IN(PH_G3)) {
        gm::DenseSched S{129, 8, c.G, c.bid, (const char*)(ws + WS_MIX), (const char*)(ws + WS_WOUTAB), D * 2, D * 2, 0};
        gm::EpiResid E{c.in[I_X], c.out, HMPAD};
        gm::gemm_phase(c.lds, S, E, D / 64, D * 2, D * 2); SEAM(PH_G3); }
    if (IN(PH_NORM1)) { norm_phase(c, c.out, c.in[I_FFNNORM]); ph_moecvt(c); SEAM(PH_NORM1); }
    if (IN(PH_G4)) {
        gm::DenseSched S{129, 44, c.G, c.bid, (const char*)XN, (const char*)(ws + WS_WGU), D * 2, D * 2, 0};
        gm::EpiSwiglu E{(bf16*)(ws + WS_ACT), DFF};
        gm::gemm_phase(c.lds, S, E, D / 64, D * 2, D * 2); SEAM(PH_G4); }
    if (IN(PH_G5)) {
        gm::DenseSched S{129, 8, c.G, c.bid, (const char*)(ws + WS_ACT), (const char*)(ws + WS_WDOWN), DFF * 2, DFF * 2, 0};
        gm::EpiResid E{c.out, c.out, HMPAD};
        gm::gemm_phase(c.lds, S, E, DFF / 64, DFF * 2, DFF * 2); SEAM(PH_G5); }
    if (IN(PH_NORM2)) { norm_phase(c, c.out, c.in[I_CNORM]); SEAM(PH_NORM2); }
    if (IN(PH_G6)) {
        gm::DenseSched S{129, NCP / 256, c.G, c.bid, (const char*)XN, (const char*)(ws + WS_WINC), D * 2, D * 2, 0};
        gm::EpiBf16 E{(bf16*)(ws + WS_Z1), NCP, 0};
        gm::gemm_phase(c.lds, S, E, D / 64, D * 2, D * 2); SEAM(PH_G6); }
    if (IN(PH_ROPE)) { ph_rope(c); SEAM(PH_ROPE); }
    if (IN(PH_INDEX)) { ph_index(c); SEAM(PH_INDEX); }
    if (IN(PH_ATTN)) { ph_attn(c); SEAM(PH_ATTN); }
    if (IN(PH_G7)) {
        gm::DenseSched S{128, 8, c.G, c.bid, (const char*)(ws + WS_ATT), (const char*)(ws + WS_WOUTC), D * 2, D * 2, 0};
        gm::EpiResid E{c.out, c.out, HMPAD};
        gm::gemm_phase(c.lds, S, E, D / 64, D * 2, D * 2); SEAM(PH_G7); }
    if (IN(PH_R1)) { ph_r1(c); SEAM(PH_R1); }
    if (IN(PH_R2)) { ph_r2(c); SEAM(PH_R2); }
#define MOE_PASS(p, PHA, PHB) \
    if (IN(PHA)) { const int ntl = (int)ld_agent((const unsigned*)(ws + WS_MOET) + MT_NTILES); int nM = ntl - (p) * MOE_PASS_TILES; nM = nM < 0 ? 0 : (nM > MOE_PASS_TILES ? MOE_PASS_TILES : nM); \
        gm::MoeSched S{nM, 56, c.G, c.bid, (const char*)(ws + WS_XG), D * 2, (p) * MOE_PASS_TILES, (const char*)(ws + WS_WMGU), D * 2, (size_t)14336 * D * 2, (const unsigned*)(ws + WS_MOET) + MT_TILEEXP, (p) * MOE_PASS_TILES}; \
        gm::EpiSwiglu E{(bf16*)(ws + WS_ACT2), DEXP}; \
        gm::gemm_phase(c.lds, S, E, D / 64, D * 2, D * 2); SEAM(PHA); } \
    if (IN(PHB)) { const int ntl = (int)ld_agent((const unsigned*)(ws + WS_MOET) + MT_NTILES); int nM = ntl - (p) * MOE_PASS_TILES; nM = nM < 0 ? 0 : (nM > MOE_PASS_TILES ? MOE_PASS_TILES : nM); \
        gm::MoeSched S{nM, 8, c.G, c.bid, (const char*)(ws + WS_ACT2), DEXP * 2, 0, (const char*)(ws + WS_WMD), DEXP * 2, (size_t)D * DEXP * 2, (const unsigned*)(ws + WS_MOET) + MT_TILEEXP, (p) * MOE_PASS_TILES}; \
        gm::EpiBf16 E{(bf16*)(ws + WS_Y), D, (p) * MOE_PASS_TILES * 256}; \
        gm::gemm_phase(c.lds, S, E, DEXP / 64, DEXP * 2, DEXP * 2); SEAM(PHB); }
    MOE_PASS(0, PH_M0A, PH_M0B)
    MOE_PASS(1, PH_M1A, PH_M1B)
    MOE_PASS(2, PH_M2A, PH_M2B)
    if (IN(PH_FINAL)) { ph_final(c); }
#undef IN
#undef SEAM
}

extern "C" void kernel_launch(void* const* d_in, const int* in_sizes, int n_in, void* d_out, int out_size, void* d_ws, size_t ws_size, hipStream_t stream) {
    static int grid = 0;
    if (grid == 0) {
        if (n_in != 28 || ws_size < WS_END) { fprintf(stderr, "kernel_launch: need 28 inputs and >= %zu bytes of workspace; got %d, %zu\n", (size_t)WS_END, n_in, ws_size); }
        int dev = 0, cus = 0, per_cu = 0;
        hipGetDevice(&dev); hipDeviceGetAttribute(&cus, hipDeviceAttributeMultiprocessorCount, dev);
        if (hipFuncSetAttribute((const void*)mega, hipFuncAttributeMaxDynamicSharedMemorySize, LDS_BYTES) != hipSuccess) fprintf(stderr, "kernel_launch: hipFuncSetAttribute failed\n");
        if (hipOccupancyMaxActiveBlocksPerMultiprocessor(&per_cu, (const void*)mega, 512, LDS_BYTES) != hipSuccess || per_cu < 1) fprintf(stderr, "kernel_launch: occupancy query says %d\n", per_cu);
        (void)hipGetLastError();
        grid = cus > 0 ? cus : 256;
        if (grid % 8) grid -= grid % 8;
    }
    hipMemsetAsync((char*)d_ws + WS_CTL, 0, 1 * MiB, stream);
    Args a{};
    for (int i = 0; i < 28; ++i) a.in[i] = (const float*)d_in[i];
    a.out = (float*)d_out; a.ws = (unsigned char*)d_ws;
#if N_LAUNCH_MODE == 1
    a.ph_lo = 0; a.ph_hi = NPH;
    hipLaunchKernelGGL(mega, dim3(grid), dim3(512), LDS_BYTES, stream, a);
#else
    for (int p = 0; p < NPH; ++p) { a.ph_lo = p; a.ph_hi = p + 1; hipLaunchKernelGGL(mega, dim3(grid), dim3(512), LDS_BYTES, stream, a); }
#endif
    const hipError_t le = hipPeekAtLastError();
    if (le != hipSuccess) fprintf(stderr, "kernel_launch: launch failed: %s\n", hipGetErrorName(le));
}
```

```cpp
#include <hip/hip_runtime.h>
#include <cstdio>
#include <cstdint>

#define GAS __attribute__((address_space(1)))
#define LAS __attribute__((address_space(3)))
typedef unsigned short bf16;
typedef unsigned v4u __attribute__((ext_vector_type(4)));
typedef unsigned v2u __attribute__((ext_vector_type(2)));
typedef float f32x4 __attribute__((ext_vector_type(4)));
typedef float f32x2 __attribute__((ext_vector_type(2)));
typedef short bf16x8 __attribute__((ext_vector_type(8)));
typedef _Float16 h2_t __attribute__((ext_vector_type(2)));
typedef short s16x4_t __attribute__((ext_vector_type(4)));
typedef int v2i_t __attribute__((ext_vector_type(2)));

#ifndef G3_F8
#define G3_F8 1
#endif
#ifndef G7_F8
#define G7_F8 1
#endif
#ifndef N_LAUNCH_MODE
#define N_LAUNCH_MODE 1
#endif

constexpr int D = 2048, SEQ = 16384, NMETA = 16, TT = 16400;
constexpr int MS = 32768;
constexpr int MR = 32784;
constexpr int MP = 33024;
constexpr int NAB = 5136, NABP = 5376, NC = 3656, NCP = 3840, DFF = 5632, DEXP = 7168;
constexpr int GLA_UNITS = 4 + 2 * 256 * 4;
constexpr int MOE_PASS_TILES = 96;
constexpr float EPS = 1e-6f;
constexpr float MOE_WS_GU = 32.0f, MOE_WS_D = 64.0f;
__device__ __forceinline__ size_t kip_off(int t, int ch) { return ((size_t)(t >> 4) * 128 + (ch >> 2) * 64 + (ch & 3) * 16 + (t & 15)) * 8; }
constexpr int KIP_STRIDE = TT + 272;

constexpr size_t MiB = 1u << 20;
constexpr size_t WS_CTL = 0;
constexpr size_t WS_HMPAD = 1 * MiB;
constexpr size_t WS_ROPE = 3 * MiB;
constexpr size_t WS_LSUM = 6 * MiB + 512 * 1024;
constexpr size_t WS_DEC = 8 * MiB;
constexpr size_t WS_WIS = 10 * MiB;
constexpr size_t WS_MOET = 12 * MiB;
constexpr size_t WS_TOP = 13 * MiB;
constexpr size_t WS_XS = 13 * MiB + 800 * 1024;
constexpr size_t WS_WSC = 12 * MiB + 64 * 1024;
constexpr size_t WS_WINC = 14 * MiB;
constexpr size_t WS_WOUTC = 29 * MiB;
constexpr size_t WS_XN = 37 * MiB;
constexpr size_t WS_WM = 166 * MiB;
constexpr size_t WS_WMGU = WS_WM, WS_WMD = WS_WM + 224 * MiB;
constexpr size_t WS_R = 838 * MiB;
constexpr size_t WS_Z0 = 166 * MiB;
constexpr size_t WS_XC = 505 * MiB;
constexpr size_t WS_RI = 570 * MiB;
constexpr size_t WS_WINAB = WS_R + 0 * MiB;
constexpr size_t WS_WRI = WS_R + 21 * MiB;
constexpr size_t WS_WOUTAB = WS_R + 22 * MiB;
constexpr size_t WS_WGU = WS_R + 30 * MiB;
constexpr size_t WS_WDOWN = WS_R + 74 * MiB;
constexpr size_t WS_MIX = WS_R + 96 * MiB;
constexpr size_t WS_DST = WS_R + 225 * MiB;
constexpr size_t WS_ST = WS_R + 482 * MiB;
constexpr size_t WS_ACT = WS_R + 225 * MiB;
constexpr size_t WS_QDG = WS_R + 610 * MiB;
constexpr size_t WS_KDG = WS_R + 643 * MiB;
constexpr size_t WS_KDTG = WS_R + 676 * MiB;
constexpr size_t WS_VTG = WS_R + 709 * MiB;
constexpr size_t WS_Z1 = WS_R + 0 * MiB;
constexpr size_t WS_KIP = WS_R + 242 * MiB;
constexpr size_t WS_SEL = WS_R + 247 * MiB;
constexpr size_t WS_SELCNT = WS_R + 262 * MiB;
constexpr size_t WS_ATT = WS_R + 263 * MiB;
constexpr size_t WS_K8 = WS_R + 392 * MiB;
constexpr size_t WS_V8 = WS_R + 409 * MiB;
constexpr size_t WS_XG = WS_R + 0 * MiB;
constexpr size_t WS_ACT2 = WS_R + 264 * MiB;
constexpr size_t WS_Y = WS_R + 600 * MiB;
constexpr size_t WS_END = WS_R + 864 * MiB;
constexpr int MT_BLKCNT = 0;
constexpr int MT_TILEEXP = 8192;
constexpr int MT_NTILES = 8192 + 512;
constexpr int CW_BAR = 4096;
constexpr int CW_WMAX = 65536;
constexpr int WMX_AB = 0, WMX_GU = 5376, WMX_C = 16640;

constexpr int LDS_BYTES = 159744;
constexpr int LDS_MISC = 158720;

__device__ __forceinline__ float bf2f(bf16 v) { return __builtin_bit_cast(float, (unsigned)v << 16); }
typedef __bf16 bf2_t __attribute__((ext_vector_type(2)));
__device__ __forceinline__ unsigned pk2(float lo, float hi) { const f32x2 v = {lo, hi}; return __builtin_bit_cast(unsigned, __builtin_convertvector(v, bf2_t)); }
__device__ __forceinline__ unsigned f2bf(float f) { return pk2(f, 0.f) & 0xffffu; }
__device__ __forceinline__ unsigned f8x4(float a, float b, float c, float d) {
    unsigned w = 0u; w = __builtin_amdgcn_cvt_pk_fp8_f32(a, b, w, false); w = __builtin_amdgcn_cvt_pk_fp8_f32(c, d, w, true); return w; }
typedef int v8i_t __attribute__((ext_vector_type(8)));
typedef int v4i_t __attribute__((ext_vector_type(4)));
template <int CTRL> __device__ __forceinline__ float dpp_(float v) { return __builtin_bit_cast(float, __builtin_amdgcn_update_dpp(0, __builtin_bit_cast(int, v), CTRL, 0xf, 0xf, true)); }
__device__ __forceinline__ float row_sum16(float v) { v += dpp_<0xB1>(v); v += dpp_<0x4E>(v); v += dpp_<0x124>(v); v += dpp_<0x128>(v); return v; }
__device__ __forceinline__ float row_max16(float v) { v = fmaxf(v, dpp_<0xB1>(v)); v = fmaxf(v, dpp_<0x4E>(v)); v = fmaxf(v, dpp_<0x124>(v)); v = fmaxf(v, dpp_<0x128>(v)); return v; }
__device__ __forceinline__ float wave_sum(float v) { v = row_sum16(v); v += __shfl_xor(v, 16); v += __shfl_xor(v, 32); return v; }
__device__ __forceinline__ float wave_max(float v) { v = row_max16(v); v = fmaxf(v, __shfl_xor(v, 16)); v = fmaxf(v, __shfl_xor(v, 32)); return v; }
#define LDS_WAIT() asm volatile("s_waitcnt lgkmcnt(0)" ::: "memory")
#define VM_WAIT() asm volatile("s_waitcnt vmcnt(0)" ::: "memory")
__device__ __forceinline__ float rcp_(float x) { return __builtin_amdgcn_rcpf(x); }
__device__ __forceinline__ float sigmoidf_(float x) { return rcp_(1.0f + __expf(-x)); }
__device__ __forceinline__ float siluf_(float x) { return x * rcp_(1.0f + __expf(-x)); }
__device__ __forceinline__ float gelu_tanh(float x) { const float u = 0.7978845608028654f * (x + 0.044715f * x * x * x); return x * rcp_(1.0f + __expf(-2.0f * u)); }
__device__ __forceinline__ unsigned ld_agent(const unsigned* p) { return __hip_atomic_load(p, __ATOMIC_RELAXED, __HIP_MEMORY_SCOPE_AGENT); }

__device__ __forceinline__ void unpack8(float (&o)[8], const v4u x) {
    const unsigned a[4] = {x.x, x.y, x.z, x.w};
#pragma unroll
    for (int k = 0; k < 4; ++k) { o[2 * k] = __builtin_bit_cast(float, a[k] << 16); o[2 * k + 1] = __builtin_bit_cast(float, a[k] & 0xffff0000u); }
}
#define XB_TMO      128
#define XB_XCNT(j)  (256  + 64 * (j))
#define XB_XSUB(j)  (1280 + 64 * (j))
#define XB_XGEN(j)  (2304 + 64 * (j))
#define XB_TOP      3328
#define XB_TOPGEN   3392
#define XCD_BAR_WORDS 3456
#define XB_SPIN_CAP (1u << 21)
__device__ __forceinline__ unsigned xb_ld(unsigned* p)              { return __hip_atomic_load(p, __ATOMIC_RELAXED, __HIP_MEMORY_SCOPE_AGENT); }
__device__ __forceinline__ unsigned xb_add(unsigned* p, unsigned v) { return __hip_atomic_fetch_add(p, v, __ATOMIC_RELAXED, __HIP_MEMORY_SCOPE_AGENT); }
__device__ __forceinline__ unsigned xb_xcc_id() { return (unsigned)__builtin_amdgcn_s_getreg((3 << 11) | 20) & 0xFu; }
#define XB_SPIN(cond, bar) do { unsigned _sp = 0; while (cond) { __builtin_amdgcn_s_sleep(1); \
    if ((++_sp & 255u) == 0u) { if (xb_ld(&(bar)[XB_TMO])) break; if (_sp > XB_SPIN_CAP) { atomicAdd(&(bar)[XB_TMO], 1u); break; } } } } while (0)
struct XcdBarrier { unsigned* bar; unsigned x; volatile LAS unsigned* st; };
__device__ __forceinline__ XcdBarrier xcd_barrier_post(unsigned* bar, volatile LAS unsigned* st) {
    XcdBarrier b; b.bar = bar; b.x = xb_xcc_id(); b.st = st;
    if (threadIdx.x == 0) (void)xb_add(&bar[XB_XCNT(b.x)], 1u);
    return b;
}
__device__ __forceinline__ void xcd_barrier_complete(unsigned* bar, unsigned x, unsigned& nloc, unsigned& nx) {
    const unsigned G = gridDim.x * gridDim.y * gridDim.z;
    unsigned sum, cnt, mine, sp = 0u;
    for (;;) {
        sum = 0u; cnt = 0u; mine = 0u;
#pragma unroll
        for (unsigned j = 0; j < 16; ++j) { const unsigned c = xb_ld(&bar[XB_XCNT(j)]); sum += c; cnt += (c > 0u) ? 1u : 0u; mine = (j == x) ? c : mine; }
        if (sum == G) break;
        __builtin_amdgcn_s_sleep(1);
        if ((++sp & 255u) == 0u) { if (xb_ld(&bar[XB_TMO])) break; if (sp > XB_SPIN_CAP) { atomicAdd(&bar[XB_TMO], 1u); break; } }
    }
    nloc = mine > 0u ? mine : 1u; nx = cnt > 0u ? cnt : 1u;
}
__device__ __forceinline__ void xcd_barrier(const XcdBarrier& b) {
    asm volatile("s_waitcnt vmcnt(0)" ::: "memory");
    __syncthreads();
    if (threadIdx.x == 0) {
        unsigned* bar = b.bar;
        __builtin_amdgcn_s_waitcnt(0);
        unsigned nloc = b.st[0], nx = b.st[1];
        if (nloc == 0u) { xcd_barrier_complete(bar, b.x, nloc, nx); b.st[0] = nloc; b.st[1] = nx; }
        const unsigned old = xb_add(&bar[XB_XSUB(b.x)], 1u);
        const unsigned gen = old / nloc;
        if (old + 1u == (gen + 1u) * nloc) {
            __builtin_amdgcn_fence(__ATOMIC_RELEASE, "agent");
            asm volatile("s_waitcnt vmcnt(0)" ::: "memory");
            const unsigned og = xb_add(&bar[XB_TOP], 1u);
            const unsigned tg = og / nx;
            if (og + 1u == (tg + 1u) * nx) xb_add(&bar[XB_TOPGEN], 1u);
            else XB_SPIN(xb_ld(&bar[XB_TOPGEN]) == tg, bar);
            __builtin_amdgcn_fence(__ATOMIC_ACQUIRE, "agent");
            xb_add(&bar[XB_XGEN(b.x)], 1u);
            asm volatile("s_waitcnt vmcnt(0)" ::: "memory");
        } else {
            XB_SPIN(xb_ld(&bar[XB_XGEN(b.x)]) == gen, bar);
            __builtin_amdgcn_fence(__ATOMIC_ACQUIRE, "agent");
            asm volatile("s_waitcnt vmcnt(0)" ::: "memory");
        }
    }
    __syncthreads();
}

struct Args { const float* in[28]; float* out; unsigned char* ws; unsigned long long dup; int ph_lo, ph_hi; };
struct InTab { __device__ __forceinline__ const float* operator[](int i) const {
    return ((const float* const volatile __attribute__((address_space(4)))*)__builtin_amdgcn_kernarg_segment_ptr())[i]; } };
struct Ctx {
    InTab in; float* out; unsigned char* ws; LAS unsigned char* lds;
    int tid, lane, wave, G, bid;
};
enum { I_X = 0, I_META, I_ABNORM, I_ABWIN, I_CONVW, I_CONVB, I_WR, I_BR, I_WI, I_BI, I_LAM, I_WGK, I_BGK, I_GLANORM, I_ABWOUT,
       I_FFNNORM, I_FFNG, I_FFNU, I_FFND, I_CNORM, I_CWIN, I_CWOUT, I_MOENORM, I_ROUTER, I_MOEG, I_MOEU, I_MOED, I_FINALNORM };

__device__ __forceinline__ int row_of(int b, int t) { return t < NMETA ? MS + t : b * SEQ + (t - NMETA); }

namespace gm {
#ifndef GM_WGM
#define GM_WGM 4
#endif
constexpr int BM = 256, BK = 64, HALF = 128, HTB = HALF * BK * 2, STAGE_BYTES = 8 * HTB, NXCD = 8, WGM = GM_WGM;
__device__ __forceinline__ int lds_byte(int r, int c) { const int st = (r >> 4) * 2 + (c >> 5), rr = r & 15, cc = c & 31, ob = rr * 64 + cc * 2; return st * 1024 + (ob ^ (((ob >> 9) & 1) << 5)); }
__device__ __forceinline__ void stage_rc(int b, int& R, int& C) { const int st = b / 1024, sb = b % 1024, swz = sb ^ (((sb >> 9) & 1) << 5); R = (st >> 1) * 16 + swz / 64; C = (st & 1) * 32 + (swz % 64) / 2; }
__device__ __forceinline__ int perm32(int rho) { const int n = rho >> 4, i = rho & 15; return 8 * (i >> 2) + 4 * n + (i & 3); }
struct Unit { int pm, pn, aux; };
__device__ __forceinline__ bool tile_order(int i, int G, int c, int nM, int nN, int& pm, int& pn) {
    const int nwg = nM * nN; const long L = (long)i * G + c; if (L >= nwg) return false;
    int wgid = (int)L; { const int q = nwg / NXCD, r = nwg % NXCD, xcd = wgid % NXCD, off = wgid / NXCD; wgid = (xcd < r ? xcd * (q + 1) : r * (q + 1) + (xcd - r) * q) + off; }
    const int nig = WGM * nN, gid = wgid / nig, fm = gid * WGM, gsz = (nM - fm) < WGM ? (nM - fm) : WGM;
    pm = fm + ((wgid % nig) % gsz); pn = (wgid % nig) / gsz; return true;
}
struct DenseSched {
    int nM, nN, G, c; const char* A; const char* B; unsigned lda, ldb; int gate_mode;
    __device__ __forceinline__ bool next(int i, Unit& u) const { u.aux = 0; return tile_order(i, G, c, nM, nN, u.pm, u.pn); }
    __device__ __forceinline__ const char* a_ptr(const Unit& u) const { return A + (size_t)u.pm * 256 * lda + (gate_mode ? (size_t)(u.pn >> 1) * 512 : 0); }
    __device__ __forceinline__ const char* b_ptr(const Unit& u) const { return B + (size_t)u.pn * 256 * ldb; }
};
struct MoeSched {
    int nM, nN, G, c; const char* A; unsigned lda; int a_tile0; const char* B; unsigned ldb; size_t bexp; const unsigned* tile_expert; int t0;
    __device__ __forceinline__ bool next(int i, Unit& u) const {
        if (!tile_order(i, G, c, nM, nN, u.pm, u.pn)) return false;
        u.aux = (int)__builtin_amdgcn_readfirstlane(ld_agent(tile_expert + t0 + u.pm)) & 7; return true; }
    __device__ __forceinline__ const char* a_ptr(const Unit& u) const { return A + (size_t)(a_tile0 + u.pm) * 256 * lda; }
    __device__ __forceinline__ const char* b_ptr(const Unit& u) const { return B + (size_t)u.aux * bexp + (size_t)u.pn * 256 * ldb; }
};

struct EpiBf16 {
    static constexpr bool PERM = true;
    bf16* O; int ldc; int row_off; float s = 1.0f;
    __device__ __forceinline__ void operator()(const f32x4 (&acc)[2][2][4][2], const Unit& u, int wr, int wc, int fr, int fq) const {
        const int row0 = row_off + u.pm * BM + wr * 64 + fr, col0 = u.pn * BM + wc * 32 + 8 * fq;
#pragma unroll
        for (int ai = 0; ai < 2; ++ai)
#pragma unroll
            for (int m = 0; m < 4; ++m) { bf16* rowp = O + (size_t)(row0 + ai * HALF + m * 16) * ldc + col0;
#pragma unroll
                for (int bj = 0; bj < 2; ++bj) { const f32x4 v0 = acc[ai][bj][m][0] * s, v1 = acc[ai][bj][m][1] * s;
                    v4u w; w.x = pk2(v0[0], v0[1]); w.y = pk2(v0[2], v0[3]); w.z = pk2(v1[0], v1[1]); w.w = pk2(v1[2], v1[3]);
                    *(v4u*)(rowp + bj * HALF) = w; } }
    }
};
struct EpiBf16I8 {
    static constexpr bool PERM = true;
    bf16* O; int ldc; const float* xs; const float* wsc;
    __device__ __forceinline__ void operator()(const f32x4 (&acc)[2][2][4][2], const Unit& u, int wr, int wc, int fr, int fq) const {
        const int row0 = u.pm * BM + wr * 64 + fr, col0 = u.pn * BM + wc * 32 + 8 * fq;
        f32x4 cs[2][2];
#pragma unroll
        for (int bj = 0; bj < 2; ++bj) { cs[bj][0] = *(const f32x4*)(wsc + col0 + bj * HALF); cs[bj][1] = *(const f32x4*)(wsc + col0 + bj * HALF + 4); }
#pragma unroll
        for (int ai = 0; ai < 2; ++ai)
#pragma unroll
            for (int m = 0; m < 4; ++m) { const int row = row0 + ai * HALF + m * 16; const float rs = xs[row]; bf16* rowp = O + (size_t)row * ldc + col0;
#pragma unroll
                for (int bj = 0; bj < 2; ++bj) { const v4i_t i0 = __builtin_bit_cast(v4i_t, acc[ai][bj][m][0]), i1 = __builtin_bit_cast(v4i_t, acc[ai][bj][m][1]);
                    float o[8];
#pragma unroll
                    for (int j = 0; j < 4; ++j) { o[j] = (float)i0[j] * rs * cs[bj][0][j]; o[4 + j] = (float)i1[j] * rs * cs[bj][1][j]; }
                    v4u w; w.x = pk2(o[0], o[1]); w.y = pk2(o[2], o[3]); w.z = pk2(o[4], o[5]); w.w = pk2(o[6], o[7]);
                    *(v4u*)(rowp + bj * HALF) = w; } }
    }
};
struct EpiSwigluI8 {
    static constexpr bool PERM = true;
    unsigned char* O; int ldc; const float* xs; const float* wsc;
    __device__ __forceinline__ void operator()(const f32x4 (&acc)[2][2][4][2], const Unit& u, int wr, int wc, int fr, int fq) const {
        const int row0 = u.pm * BM + wr * 64 + fr, col0 = u.pn * HALF + wc * 32 + 8 * fq, wrow0 = u.pn * BM + wc * 32 + 8 * fq;
        f32x4 cs[2][2];
#pragma unroll
        for (int bj = 0; bj < 2; ++bj) { cs[bj][0] = *(const f32x4*)(wsc + wrow0 + bj * HALF); cs[bj][1] = *(const f32x4*)(wsc + wrow0 + bj * HALF + 4); }
#pragma unroll
        for (int ai = 0; ai < 2; ++ai)
#pragma unroll
            for (int m = 0; m < 4; ++m) { const int row = row0 + ai * HALF + m * 16; const float rs = xs[row]; unsigned char* rowp = O + (size_t)row * ldc + col0;
                float o[8];
#pragma unroll
                for (int n = 0; n < 2; ++n) { const v4i_t ig = __builtin_bit_cast(v4i_t, acc[ai][0][m][n]), iu = __builtin_bit_cast(v4i_t, acc[ai][1][m][n]);
#pragma unroll
                    for (int j = 0; j < 4; ++j) o[4 * n + j] = siluf_((float)ig[j] * rs * cs[0][n][j]) * ((float)iu[j] * rs * cs[1][n][j]); }
                v2u w; w.x = f8x4(o[0], o[1], o[2], o[3]); w.y = f8x4(o[4], o[5], o[6], o[7]);
                *(v2u*)rowp = w; }
    }
};
struct EpiSwigluF8 {
    static constexpr bool PERM = true;
    unsigned char* O; int ldc; float s;
    __device__ __forceinline__ void operator()(const f32x4 (&acc)[2][2][4][2], const Unit& u, int wr, int wc, int fr, int fq) const {
        const int row0 = u.pm * BM + wr * 64 + fr, col0 = u.pn * HALF + wc * 32 + 8 * fq;
#pragma unroll
        for (int ai = 0; ai < 2; ++ai)
#pragma unroll
            for (int m = 0; m < 4; ++m) { unsigned char* rowp = O + (size_t)(row0 + ai * HALF + m * 16) * ldc + col0;
                float o[8];
#pragma unroll
                for (int n = 0; n < 2; ++n)
#pragma unroll
                    for (int j = 0; j < 4; ++j) o[4 * n + j] = siluf_(acc[ai][0][m][n][j] * s) * (acc[ai][1][m][n][j] * s);
                v2u w; w.x = f8x4(o[0], o[1], o[2], o[3]); w.y = f8x4(o[4], o[5], o[6], o[7]);
                *(v2u*)rowp = w; }
    }
};
struct EpiSwiglu {
    static constexpr bool PERM = true;
    bf16* O; int ldc;
    __device__ __forceinline__ void operator()(const f32x4 (&acc)[2][2][4][2], const Unit& u, int wr, int wc, int fr, int fq) const {
        const int row0 = u.pm * BM + wr * 64 + fr, col0 = u.pn * HALF + wc * 32 + 8 * fq;
#pragma unroll
        for (int ai = 0; ai < 2; ++ai)
#pragma unroll
            for (int m = 0; m < 4; ++m) { bf16* rowp = O + (size_t)(row0 + ai * HALF + m * 16) * ldc + col0;
                float o[8];
#pragma unroll
                for (int n = 0; n < 2; ++n)
#pragma unroll
                    for (int j = 0; j < 4; ++j) o[4 * n + j] = siluf_(acc[ai][0][m][n][j]) * acc[ai][1][m][n][j];
                v4u w; w.x = pk2(o[0], o[1]); w.y = pk2(o[2], o[3]); w.z = pk2(o[4], o[5]); w.w = pk2(o[6], o[7]);
                *(v4u*)rowp = w; }
    }
};
struct EpiResid {
    static constexpr bool PERM = false;
    const float* src; float* dst; float* hmpad; float sc = 1.0f;
    __device__ __forceinline__ void operator()(const f32x4 (&acc)[2][2][4][2], const Unit& u, int wr, int wc, int fr, int fq) const {
        const bool meta = (u.pm == 128);
        const float* s = meta ? hmpad : src; float* d = meta ? hmpad : dst;
        const int row0 = (meta ? 0 : u.pm * BM) + wr * 64 + fr, col0 = u.pn * BM + wc * 32 + 4 * fq;
#pragma unroll
        for (int ai = 0; ai < 2; ++ai)
#pragma unroll
            for (int m = 0; m < 4; ++m) { const size_t ro = (size_t)(row0 + ai * HALF + m * 16) * D + col0;
#pragma unroll
                for (int bj = 0; bj < 2; ++bj)
#pragma unroll
                    for (int n = 0; n < 2; ++n) { const size_t o = ro + bj * HALF + n * 16; *(f32x4*)(d + o) = *(const f32x4*)(s + o) + acc[ai][bj][m][n] * sc; } }
    }
};

template <class Epi, class Sched, int MODE = 0>
__device__ __forceinline__ void gemm_phase(LAS unsigned char* lds, const Sched& S, const Epi& E, const int nt, const unsigned lda, const unsigned ldb) {
    const int tid = threadIdx.x, wid = __builtin_amdgcn_readfirstlane(tid >> 6), lane = tid & 63, wr = wid >> 2, wc = wid & 3, fr = lane & 15, fq = lane >> 4;
    unsigned voffA[2], voffB[2];
#pragma unroll
    for (int i = 0; i < 2; ++i) { int R, C; stage_rc(tid * 16 + i * 8192, R, C); const int Rb = Epi::PERM ? ((R & ~31) + perm32(R & 31)) : R;
        voffA[i] = (unsigned)R * lda + (unsigned)C * 2u; voffB[i] = (unsigned)Rb * ldb + (unsigned)C * 2u; }
    const size_t kstep = (size_t)(BK * 2);
    const size_t hstepA = (size_t)HALF * lda, hstepB = (size_t)HALF * ldb;
    const unsigned ldsw = (unsigned)wid * 1024u;
    const int aoff = lds_byte(wr * 64 + fr, fq * 8), boff = lds_byte(wc * 32 + fr, fq * 8);
#define PG8_SA(b, h) (((b) * 2 + (h)) * HTB)
#define PG8_SB(b, h) ((4 + (b) * 2 + (h)) * HTB)
#define PG8_STAGE(bufoff, gbase, voff) do { _Pragma("unroll") for (int _i = 0; _i < 2; ++_i) \
        __builtin_amdgcn_global_load_lds((const unsigned*)((const char*)(gbase) + (voff)[_i]), (LAS unsigned*)(lds + (bufoff) + ldsw + _i * 8192), 16, 0, 0); } while (0)
#define PG8_LDA(dst, b, h) do { _Pragma("unroll") for (int m = 0; m < 4; ++m) { if constexpr (MODE == 1) { dst##8[m].lo = *(const LAS v4i_t*)(lds + PG8_SA(b, h) + aoff + m * 2048); dst##8[m].hi = *(const LAS v4i_t*)(lds + PG8_SA(b, h) + aoff + m * 2048 + 1024); } \
        else { _Pragma("unroll") for (int k = 0; k < 2; ++k) dst[m][k] = *(const LAS bf16x8*)(lds + PG8_SA(b, h) + aoff + m * 2048 + k * 1024); } } } while (0)
#define PG8_LDB(dst, b, h) do { _Pragma("unroll") for (int n = 0; n < 2; ++n) { if constexpr (MODE == 1) { dst##8[n].lo = *(const LAS v4i_t*)(lds + PG8_SB(b, h) + boff + n * 2048); dst##8[n].hi = *(const LAS v4i_t*)(lds + PG8_SB(b, h) + boff + n * 2048 + 1024); } \
        else { _Pragma("unroll") for (int k = 0; k < 2; ++k) dst[n][k] = *(const LAS bf16x8*)(lds + PG8_SB(b, h) + boff + n * 2048 + k * 1024); } } } while (0)
#define PG8_MMA(ai, bj, At, Bt) do { __builtin_amdgcn_s_setprio(1); _Pragma("unroll") for (int m = 0; m < 4; ++m) _Pragma("unroll") for (int n = 0; n < 2; ++n) { \
        if constexpr (MODE == 1) asm volatile("v_mfma_scale_f32_16x16x128_f8f6f4 %0, %1, %2, %0, %3, %3 op_sel_hi:[0,0,0]" : "+v"(acc[ai][bj][m][n]) : "v"(Bt##8[n]), "v"(At##8[m]), "v"(f8scale)); \
        else if constexpr (MODE == 2) { _Pragma("unroll") for (int k = 0; k < 2; ++k) acc[ai][bj][m][n] = __builtin_bit_cast(f32x4, __builtin_amdgcn_mfma_i32_16x16x64_i8(__builtin_bit_cast(v4i_t, Bt[n][k]), __builtin_bit_cast(v4i_t, At[m][k]), __builtin_bit_cast(v4i_t, acc[ai][bj][m][n]), 0, 0, 0)); } \
        else { _Pragma("unroll") for (int k = 0; k < 2; ++k) acc[ai][bj][m][n] = __builtin_amdgcn_mfma_f32_16x16x32_bf16(Bt[n][k], At[m][k], acc[ai][bj][m][n], 0, 0, 0); } } \
        __builtin_amdgcn_s_setprio(0); } while (0)
#define PG8_WAIT_V(n) asm volatile("s_waitcnt vmcnt(" #n ")" ::: "memory")
#define PG8_WAIT_L(n) asm volatile("s_waitcnt lgkmcnt(" #n ")" ::: "memory")
#define PG8_BAR __builtin_amdgcn_s_barrier()
#define PG8_SCHED __builtin_amdgcn_sched_barrier(0)
    Unit cur, nxt; int ui = 0;
    if (!S.next(0, cur)) return;
    f32x4 acc[2][2][4][2];
#pragma unroll
    for (int a = 0; a < 2; ++a)
#pragma unroll
        for (int b = 0; b < 2; ++b)
#pragma unroll
            for (int m = 0; m < 4; ++m)
#pragma unroll
                for (int n = 0; n < 2; ++n) acc[a][b][m][n] = (f32x4){0.f, 0.f, 0.f, 0.f};
    const int f8scale = 0x7F7F7F7F;
    bf16x8 At[4][2], B0[2][2], B1[2][2]; v8i_t At8[4], B08[2], B18[2];
    const char* cA = S.a_ptr(cur); const char* cB = S.b_ptr(cur);
    PG8_STAGE(PG8_SB(0, 0), cB, voffB); PG8_STAGE(PG8_SA(0, 0), cA, voffA); PG8_STAGE(PG8_SB(0, 1), cB + hstepB, voffB); PG8_STAGE(PG8_SA(0, 1), cA + hstepA, voffA);
    if (wr == 1) PG8_BAR;
    PG8_WAIT_V(4); PG8_BAR;
    PG8_STAGE(PG8_SB(1, 0), cB + kstep, voffB); PG8_STAGE(PG8_SA(1, 0), cA + kstep, voffA); PG8_STAGE(PG8_SB(1, 1), cB + hstepB + kstep, voffB);
    PG8_WAIT_V(6); PG8_BAR;
    for (;;) {
        const bool has_next = S.next(ui + 1, nxt);
        const char* nA = has_next ? S.a_ptr(nxt) : cA; const char* nB = has_next ? S.b_ptr(nxt) : cB;
        for (int t = 0; t < nt; t += 2) {
            const bool last = (t == nt - 2);
            const char* a1 = cA + (size_t)(t + 1) * kstep;
            const char* a2 = last ? nA : cA + (size_t)(t + 2) * kstep; const char* b2 = last ? nB : cB + (size_t)(t + 2) * kstep;
            const char* a3 = a2 + kstep; const char* b3 = b2 + kstep;
            PG8_LDB(B0, 0, 0); PG8_SCHED; PG8_LDA(At, 0, 0); PG8_STAGE(PG8_SA(1, 1), a1 + hstepA, voffA);
            PG8_WAIT_L(8); PG8_BAR; PG8_WAIT_L(0); PG8_MMA(0, 0, At, B0); PG8_BAR; PG8_SCHED;
            PG8_LDB(B1, 0, 1); PG8_STAGE(PG8_SB(0, 0), b2, voffB);
            PG8_BAR; PG8_WAIT_L(0); PG8_MMA(0, 1, At, B1); PG8_BAR;
            PG8_LDA(At, 0, 1); PG8_STAGE(PG8_SA(0, 0), a2, voffA);
            PG8_BAR; PG8_WAIT_L(0); PG8_MMA(1, 0, At, B0); PG8_BAR; PG8_SCHED;
            PG8_STAGE(PG8_SB(0, 1), b2 + hstepB, voffB);
            PG8_WAIT_V(6); PG8_BAR; PG8_MMA(1, 1, At, B1); PG8_BAR;
            PG8_LDB(B0, 1, 0); PG8_SCHED; PG8_LDA(At, 1, 0); PG8_STAGE(PG8_SA(0, 1), a2 + hstepA, voffA);
            PG8_WAIT_L(8); PG8_BAR; PG8_WAIT_L(0); PG8_MMA(0, 0, At, B0); PG8_BAR; PG8_SCHED;
            PG8_LDB(B1, 1, 1); PG8_STAGE(PG8_SB(1, 0), b3, voffB);
            PG8_BAR; PG8_WAIT_L(0); PG8_MMA(0, 1, At, B1); PG8_BAR;
            PG8_LDA(At, 1, 1); PG8_STAGE(PG8_SA(1, 0), a3, voffA);
            PG8_BAR; PG8_WAIT_L(0); PG8_MMA(1, 0, At, B0); PG8_BAR; PG8_SCHED;
            PG8_STAGE(PG8_SB(1, 1), b3 + hstepB, voffB);
            PG8_WAIT_V(6); PG8_BAR; PG8_MMA(1, 1, At, B1); PG8_BAR;
        }
        if constexpr (MODE == 1) asm volatile("s_nop 15\n\ts_nop 3" ::: "memory");
#if defined(EPI_PROBE)
        { volatile LAS unsigned* misc_ = (volatile LAS unsigned*)(lds + (158720 - 0)); const bool on_ = (blockIdx.x == 0 && tid == 0);
          unsigned long long t_ = 0; if (on_) t_ = __builtin_amdgcn_s_memrealtime();
          E(acc, cur, wr, wc, fr, fq);
          asm volatile("s_waitcnt vmcnt(0)" ::: "memory");
          if (on_) { const unsigned long long d_ = __builtin_amdgcn_s_memrealtime() - t_; const unsigned long long a_ = ((unsigned long long)misc_[18] | ((unsigned long long)misc_[19] << 32)) + d_; misc_[18] = (unsigned)a_; misc_[19] = (unsigned)(a_ >> 32); } }
#else
        E(acc, cur, wr, wc, fr, fq);
#endif
        if (!has_next) break;
#pragma unroll
        for (int a = 0; a < 2; ++a)
#pragma unroll
            for (int b = 0; b < 2; ++b)
#pragma unroll
                for (int m = 0; m < 4; ++m)
#pragma unroll
                    for (int n = 0; n < 2; ++n) acc[a][b][m][n] = (f32x4){0.f, 0.f, 0.f, 0.f};
        cur = nxt; cA = nA; cB = nB; ++ui;
    }
    PG8_WAIT_V(0);
    if (wr == 0) PG8_BAR;
    PG8_BAR;
#undef PG8_SA
#undef PG8_SB
#undef PG8_STAGE
#undef PG8_LDA
#undef PG8_LDB
#undef PG8_MMA
#undef PG8_WAIT_V
#undef PG8_WAIT_L
#undef PG8_BAR
#undef PG8_SCHED
}
}

__device__ __forceinline__ void tr_item_f8(const float* src, int ldsrc, int c0, int nvalid, unsigned char* dst8, int K, int r0, int k0, float wscale, LAS float* scr, int lane) {
    const int kr = lane >> 4, cq = (lane & 15) * 4;
    f32x4 v[16];
    const float* sp = src + (size_t)(k0 + kr) * ldsrc + c0 + cq;
    if (cq < nvalid) {
#pragma unroll
        for (int i = 0; i < 16; ++i) v[i] = __builtin_nontemporal_load((const f32x4*)(sp + (size_t)(4 * i) * ldsrc));
    } else {
#pragma unroll
        for (int i = 0; i < 16; ++i) v[i] = (f32x4){0.f, 0.f, 0.f, 0.f};
    }
#pragma unroll
    for (int i = 0; i < 16; ++i) { LAS float* d = scr + (4 * i + kr) * 65 + cq; d[0] = v[i].x; d[1] = v[i].y; d[2] = v[i].z; d[3] = v[i].w; }
    LDS_WAIT();
    const int c = lane & 7;
#pragma unroll
    for (int j = 0; j < 8; ++j) { const int n = (lane >> 3) + 8 * j; const LAS float* s = scr + (8 * c) * 65 + n;
        v2u o; o.x = f8x4(s[0 * 65] * wscale, s[1 * 65] * wscale, s[2 * 65] * wscale, s[3 * 65] * wscale); o.y = f8x4(s[4 * 65] * wscale, s[5 * 65] * wscale, s[6 * 65] * wscale, s[7 * 65] * wscale);
        *(v2u*)(dst8 + (size_t)(r0 + n) * K + k0 + 8 * c) = o; }
    LDS_WAIT();
}
__device__ __forceinline__ void tr_item(const float* src, int ldsrc, int c0, int nvalid, bf16* dst, int K, int r0, int k0, LAS float* scr, int lane) {
    const int kr = lane >> 4, cq = (lane & 15) * 4;
    f32x4 v[16];
    const float* sp = src + (size_t)(k0 + kr) * ldsrc + c0 + cq;
    if (cq < nvalid) {
#pragma unroll
        for (int i = 0; i < 16; ++i) v[i] = __builtin_nontemporal_load((const f32x4*)(sp + (size_t)(4 * i) * ldsrc));
    } else {
#pragma unroll
        for (int i = 0; i < 16; ++i) v[i] = (f32x4){0.f, 0.f, 0.f, 0.f};
    }
#pragma unroll
    for (int i = 0; i < 16; ++i) { LAS float* d = scr + (4 * i + kr) * 65 + cq; d[0] = v[i].x; d[1] = v[i].y; d[2] = v[i].z; d[3] = v[i].w; }
    LDS_WAIT();
    const int c = lane & 7;
#pragma unroll
    for (int j = 0; j < 8; ++j) { const int n = (lane >> 3) + 8 * j; const LAS float* s = scr + (8 * c) * 65 + n;
        v4u o; o.x = pk2(s[0 * 65], s[1 * 65]); o.y = pk2(s[2 * 65], s[3 * 65]); o.z = pk2(s[4 * 65], s[5 * 65]); o.w = pk2(s[6 * 65], s[7 * 65]);
        *(v4u*)(dst + (size_t)(r0 + n) * K + k0 + 8 * c) = o; }
    LDS_WAIT();
}
__device__ __forceinline__ unsigned i8x4(float a, float b, float c, float d) {
    const int ia = (int)__builtin_rintf(a), ib = (int)__builtin_rintf(b), ic = (int)__builtin_rintf(c), id = (int)__builtin_rintf(d);
    return (unsigned)(ia & 0xff) | ((unsigned)(ib & 0xff) << 8) | ((unsigned)(ic & 0xff) << 16) | ((unsigned)id << 24);
}
struct I8Mat { const float* src; int N, nsg_src, nsg_dst, mode, off; unsigned char* dst; };
__device__ __forceinline__ I8Mat i8_mat(const Ctx& c, int m) {
    I8Mat t;
    if (m == 0) { t.src = c.in[I_ABWIN]; t.N = NAB; t.nsg_src = 81; t.nsg_dst = NABP / 64; t.mode = 0; t.off = WMX_AB; t.dst = c.ws + WS_WINAB; }
    else if (m == 1) { t.src = c.in[I_FFNG]; t.N = DFF; t.nsg_src = 88; t.nsg_dst = 88; t.mode = 1; t.off = WMX_GU; t.dst = c.ws + WS_WGU; }
    else if (m == 2) { t.src = c.in[I_FFNU]; t.N = DFF; t.nsg_src = 88; t.nsg_dst = 88; t.mode = 2; t.off = WMX_GU; t.dst = c.ws + WS_WGU; }
    else { t.src = c.in[I_CWIN]; t.N = NC; t.nsg_src = 58; t.nsg_dst = NCP / 64; t.mode = 0; t.off = WMX_C; t.dst = c.ws + WS_WINC; }
    return t;
}
__device__ __forceinline__ int i8_dstgroup(int mode, int sg) { return mode == 0 ? sg : ((sg >> 1) * 4 + (mode == 2 ? 2 : 0) + (sg & 1)); }
__device__ __forceinline__ void ph_colmax(const Ctx& c) {
    unsigned* WMAX = (unsigned*)(c.ws + WS_CTL) + CW_WMAX;
    const int gw = c.bid * 8 + c.wave, NGW = c.G * 8, lane = c.lane;
    for (int it = gw; it < (81 + 88 + 88 + 58) * 8; it += NGW) {
        int r = it >> 3; const int kq = it & 7; int m = 0;
        if (r >= 81) { r -= 81; m = 1; if (r >= 88) { r -= 88; m = 2; if (r >= 88) { r -= 88; m = 3; } } }
        const I8Mat t = i8_mat(c, m); const int col = 64 * r + lane;
        if (col < t.N) { const float* p = t.src + (size_t)(kq * 256) * t.N + col; float mx = 0.f;
            for (int k0 = 0; k0 < 256; k0 += 16) { float v[16];
#pragma unroll
                for (int k = 0; k < 16; ++k) v[k] = __builtin_nontemporal_load(p + (size_t)(k0 + k) * t.N);
#pragma unroll
                for (int k = 0; k < 16; ++k) mx = fmaxf(mx, fabsf(v[k])); }
            __hip_atomic_fetch_max(WMAX + t.off + 64 * i8_dstgroup(t.mode, r) + lane, __builtin_bit_cast(unsigned, mx), __ATOMIC_RELAXED, __HIP_MEMORY_SCOPE_AGENT); }
    }
}
__device__ __forceinline__ void tr_item_i8(const float* src, int ldsrc, int c0, int nvalid, unsigned char* dst8, int K, int r0, int k0, const unsigned* wmax, float* wsc, LAS float* scr, int lane) {
    const int kr = lane >> 4, cq = (lane & 15) * 4;
    f32x4 v[16];
    { const float* sp0 = src + (size_t)(k0 + kr) * ldsrc + c0 + cq;
      if (cq < nvalid) {
#pragma unroll
          for (int i = 0; i < 16; ++i) v[i] = __builtin_nontemporal_load((const f32x4*)(sp0 + (size_t)(4 * i) * ldsrc));
      } else {
#pragma unroll
          for (int i = 0; i < 16; ++i) v[i] = (f32x4){0.f, 0.f, 0.f, 0.f};
      } }
#pragma unroll
    for (int i = 0; i < 16; ++i) { LAS float* d = scr + (4 * i + kr) * 65 + cq; d[0] = v[i].x; d[1] = v[i].y; d[2] = v[i].z; d[3] = v[i].w; }
    LDS_WAIT();
    const int cch = lane & 7;
#pragma unroll
    for (int j = 0; j < 8; ++j) { const int n = (lane >> 3) + 8 * j; const LAS float* sp = scr + (8 * cch) * 65 + n;
        const float mx = __builtin_bit_cast(float, ld_agent(wmax + r0 + n)); const float inv = mx > 0.f ? 127.0f / mx : 0.f;
        v2u o; o.x = i8x4(sp[0 * 65] * inv, sp[1 * 65] * inv, sp[2 * 65] * inv, sp[3 * 65] * inv); o.y = i8x4(sp[4 * 65] * inv, sp[5 * 65] * inv, sp[6 * 65] * inv, sp[7 * 65] * inv);
        *(v2u*)(dst8 + (size_t)(r0 + n) * K + k0 + 8 * cch) = o;
        if (k0 == 0 && cch == 0) wsc[r0 + n] = mx > 0.f ? mx * (1.0f / 127.0f) : 1.0f; }
    LDS_WAIT();
}
__device__ __forceinline__ void ph_pre2(const Ctx& c) {
    LAS float* scr = (LAS float*)(c.lds + c.wave * 16640);
    const unsigned* WMAX = (const unsigned*)(c.ws + WS_CTL) + CW_WMAX; float* WSC = (float*)(c.ws + WS_WSC);
    const int gw = c.bid * 8 + c.wave, NGW = c.G * 8;
    for (int it = gw; it < (84 + 88 + 88 + 60) * 32; it += NGW) {
        int r = it >> 5; const int kb = it & 31; int m = 0;
        if (r >= 84) { r -= 84; m = 1; if (r >= 88) { r -= 88; m = 2; if (r >= 88) { r -= 88; m = 3; } } }
        const I8Mat t = i8_mat(c, m);
        int nv = t.N - 64 * r; nv = nv < 0 ? 0 : (nv > 64 ? 64 : nv);
        tr_item_i8(t.src, t.N, 64 * r, nv, t.dst, D, 64 * i8_dstgroup(t.mode, r), 64 * kb, WMAX + t.off, WSC + t.off, scr, c.lane);
    }
}
struct TJob { const float* src; bf16* dst; int N, K, nsg, mode; float f8s; };
__device__ __forceinline__ void run_job_item(const TJob& j, int item, LAS float* scr, int lane) {
    const int nkb = j.K / 64, sg = item / nkb, kb = item % nkb;
    int nv = j.N - 64 * sg; nv = nv < 0 ? 0 : (nv > 64 ? 64 : nv);
    const int dg = j.mode == 0 ? sg : ((sg >> 1) * 4 + (j.mode == 2 ? 2 : 0) + (sg & 1));
    if (j.f8s != 0.f) tr_item_f8(j.src, j.N, 64 * sg, nv, (unsigned char*)j.dst, j.K, 64 * dg, 64 * kb, j.f8s, scr, lane);
    else tr_item(j.src, j.N, 64 * sg, nv, j.dst, j.K, 64 * dg, 64 * kb, scr, lane);
}
__device__ __forceinline__ TJob job_l0(const Ctx& c, int j) {
    TJob t; t.mode = 0; t.f8s = 0.f;
    if (j == 0) { t.src = c.in[I_ABWIN]; t.dst = (bf16*)(c.ws + WS_WINAB); t.N = NAB; t.K = D; t.nsg = NABP / 64; }
    else if (j <= 4) { const int n = j - 1; t.src = c.in[I_WR] + n * 65536; t.dst = (bf16*)(c.ws + WS_WRI) + (size_t)(n * 512) * 256; t.N = 256; t.K = 256; t.nsg = 4; }
    else if (j <= 8) { const int n = j - 5; t.src = c.in[I_WI] + n * 65536; t.dst = (bf16*)(c.ws + WS_WRI) + (size_t)(n * 512 + 256) * 256; t.N = 256; t.K = 256; t.nsg = 4; }
    else if (j == 9) { t.src = c.in[I_ABWOUT]; t.dst = (bf16*)(c.ws + WS_WOUTAB); t.N = D; t.K = D; t.nsg = 32; if (G3_F8) t.f8s = MOE_WS_GU; }
    else if (j == 10) { t.src = c.in[I_FFNG]; t.dst = (bf16*)(c.ws + WS_WGU); t.N = DFF; t.K = D; t.nsg = 88; t.mode = 1; t.f8s = MOE_WS_GU; }
    else if (j == 11) { t.src = c.in[I_FFNU]; t.dst = (bf16*)(c.ws + WS_WGU); t.N = DFF; t.K = D; t.nsg = 88; t.mode = 2; t.f8s = MOE_WS_GU; }
    else if (j == 12) { t.src = c.in[I_FFND]; t.dst = (bf16*)(c.ws + WS_WDOWN); t.N = D; t.K = DFF; t.nsg = 32; t.f8s = MOE_WS_D; }
    else if (j == 13) { t.src = c.in[I_CWIN]; t.dst = (bf16*)(c.ws + WS_WINC); t.N = NC; t.K = D; t.nsg = NCP / 64; }
    else { t.src = c.in[I_CWOUT]; t.dst = (bf16*)(c.ws + WS_WOUTC); t.N = D; t.K = D; t.nsg = 32; if (G7_F8) t.f8s = MOE_WS_GU; }
    return t;
}
__device__ __forceinline__ TJob job_moe(const Ctx& c, int j) {
    TJob t; const int e = j / 3, k = j % 3;
    if (k == 0) { t.src = c.in[I_MOEG] + (size_t)e * D * DEXP; t.dst = (bf16*)(c.ws + WS_WMGU + (size_t)e * 14336 * D); t.N = DEXP; t.K = D; t.nsg = 112; t.mode = 1; t.f8s = MOE_WS_GU; }
    else if (k == 1) { t.src = c.in[I_MOEU] + (size_t)e * D * DEXP; t.dst = (bf16*)(c.ws + WS_WMGU + (size_t)e * 14336 * D); t.N = DEXP; t.K = D; t.nsg = 112; t.mode = 2; t.f8s = MOE_WS_GU; }
    else { t.src = c.in[I_MOED] + (size_t)e * DEXP * D; t.dst = (bf16*)(c.ws + WS_WMD + (size_t)e * D * DEXP); t.N = D; t.K = DEXP; t.nsg = 32; t.mode = 0; t.f8s = MOE_WS_D; }
    return t;
}
__device__ __forceinline__ void rms_row_bf16(const float* xrow, const float* g, bf16* orow, int lane) {
    const f32x4* xr = (const f32x4*)xrow + lane; f32x4 v[8]; float s = 0.f;
#pragma unroll
    for (int j = 0; j < 8; ++j) { v[j] = xr[64 * j]; s += (v[j].x * v[j].x + v[j].y * v[j].y) + (v[j].z * v[j].z + v[j].w * v[j].w); }
    const float rstd = 1.0f / sqrtf(wave_sum(s) * (1.f / D) + EPS);
    v2u* o8 = (v2u*)orow + lane;
#pragma unroll
    for (int j = 0; j < 8; ++j) { const f32x4 gg = ((const f32x4*)g)[lane + 64 * j]; const f32x4 o = v[j] * rstd * gg; v2u w; w.x = pk2(o.x, o.y); w.y = pk2(o.z, o.w); o8[64 * j] = w; }
}
__device__ __forceinline__ const float* h_row(const Ctx& c, const float* main, int row) {
    return row < MS ? main + (size_t)row * D : (const float*)(c.ws + WS_HMPAD) + (size_t)(row - MS) * D;
}
__device__ __forceinline__ void row_load(f32x4 (&v)[8], const float* xrow, int lane) {
    const f32x4* xr = (const f32x4*)xrow + lane;
#pragma unroll
    for (int j = 0; j < 8; ++j) v[j] = xr[64 * j];
}
__device__ __forceinline__ void rms_regs_bf16(const f32x4 (&v)[8], const float* g, bf16* orow, int lane) {
    float s = 0.f;
#pragma unroll
    for (int j = 0; j < 8; ++j) s += (v[j].x * v[j].x + v[j].y * v[j].y) + (v[j].z * v[j].z + v[j].w * v[j].w);
    const float rstd = 1.0f / sqrtf(wave_sum(s) * (1.f / D) + EPS);
    v2u* o8 = (v2u*)orow + lane;
#pragma unroll
    for (int j = 0; j < 8; ++j) { const f32x4 gg = ((const f32x4*)g)[lane + 64 * j]; const f32x4 o = v[j] * rstd * gg; v2u w; w.x = pk2(o.x, o.y); w.y = pk2(o.z, o.w); o8[64 * j] = w; }
}
__device__ __forceinline__ void rms_regs_i8(const f32x4 (&v)[8], const float* g, unsigned char* orow, float* xsp, int lane) {
    float s = 0.f;
#pragma unroll
    for (int j = 0; j < 8; ++j) s += (v[j].x * v[j].x + v[j].y * v[j].y) + (v[j].z * v[j].z + v[j].w * v[j].w);
    const float rstd = 1.0f / sqrtf(wave_sum(s) * (1.f / D) + EPS);
    f32x4 o[8]; float mx = 0.f;
#pragma unroll
    for (int j = 0; j < 8; ++j) { const f32x4 gg = ((const f32x4*)g)[lane + 64 * j]; o[j] = v[j] * rstd * gg; mx = fmaxf(mx, fmaxf(fmaxf(fabsf(o[j].x), fabsf(o[j].y)), fmaxf(fabsf(o[j].z), fabsf(o[j].w)))); }
    mx = wave_max(mx); const float inv = mx > 0.f ? 127.0f / mx : 0.f;
    unsigned* o4 = (unsigned*)orow + lane;
#pragma unroll
    for (int j = 0; j < 8; ++j) o4[64 * j] = i8x4(o[j].x * inv, o[j].y * inv, o[j].z * inv, o[j].w * inv);
    if (lane == 0) *xsp = mx > 0.f ? mx * (1.0f / 127.0f) : 1.0f;
}
__device__ __forceinline__ void rms_regs_i8g(const f32x4 (&v)[8], const f32x4 (&gg)[8], unsigned char* orow, float* xsp, int lane) {
    float s = 0.f;
#pragma unroll
    for (int j = 0; j < 8; ++j) s += (v[j].x * v[j].x + v[j].y * v[j].y) + (v[j].z * v[j].z + v[j].w * v[j].w);
    const float rstd = 1.0f / sqrtf(wave_sum(s) * (1.f / D) + EPS);
    f32x4 o[8]; float mx = 0.f;
#pragma unroll
    for (int j = 0; j < 8; ++j) { o[j] = v[j] * rstd * gg[j]; mx = fmaxf(mx, fmaxf(fmaxf(fabsf(o[j].x), fabsf(o[j].y)), fmaxf(fabsf(o[j].z), fabsf(o[j].w)))); }
    mx = wave_max(mx); const float inv = mx > 0.f ? 127.0f / mx : 0.f;
    unsigned* o4 = (unsigned*)orow + lane;
#pragma unroll
    for (int j = 0; j < 8; ++j) o4[64 * j] = i8x4(o[j].x * inv, o[j].y * inv, o[j].z * inv, o[j].w * inv);
    if (lane == 0) *xsp = mx > 0.f ? mx * (1.0f / 127.0f) : 1.0f;
}
__device__ __forceinline__ void norm_phase_i8(const Ctx& c, const float* main, const float* g) {
    const int gw = c.bid * 8 + c.wave, NGW = c.G * 8;
    unsigned char* XN8 = c.ws + WS_XN; float* XS = (float*)(c.ws + WS_XS);
    f32x4 gg[8];
#pragma unroll
    for (int j = 0; j < 8; ++j) gg[j] = ((const f32x4*)g)[c.lane + 64 * j];
    f32x4 cur[8], nxt[8], nn[8];
    if (gw < MR) row_load(cur, h_row(c, main, gw), c.lane);
    if (gw + NGW < MR) row_load(nxt, h_row(c, main, gw + NGW), c.lane);
    for (int row = gw; row < MP; row += NGW) {
        const int nrow = row + 2 * NGW;
        if (nrow < MR) row_load(nn, h_row(c, main, nrow), c.lane);
        if (row < MR) rms_regs_i8g(cur, gg, XN8 + (size_t)row * D, XS + row, c.lane);
        else { v4u z = {0u, 0u, 0u, 0u}; v4u* o = (v4u*)(XN8 + (size_t)row * D); for (int j = 0; j < 2; ++j) o[c.lane + 64 * j] = z; if (c.lane == 0) XS[row] = 1.0f; }
#pragma unroll
        for (int j = 0; j < 8; ++j) { cur[j] = nxt[j]; nxt[j] = nn[j]; }
    }
}
__device__ __forceinline__ void rms_regs_f8(const f32x4 (&v)[8], const float* g, unsigned char* orow, int lane) {
    float s = 0.f;
#pragma unroll
    for (int j = 0; j < 8; ++j) s += (v[j].x * v[j].x + v[j].y * v[j].y) + (v[j].z * v[j].z + v[j].w * v[j].w);
    const float rstd = 1.0f / sqrtf(wave_sum(s) * (1.f / D) + EPS);
    unsigned* o4 = (unsigned*)orow + lane;
#pragma unroll
    for (int j = 0; j < 8; ++j) { const f32x4 gg = ((const f32x4*)g)[lane + 64 * j]; const f32x4 o = v[j] * rstd * gg; o4[64 * j] = f8x4(o.x, o.y, o.z, o.w); }
}
__device__ __forceinline__ void norm_phase_f8(const Ctx& c, const float* main, const float* g) {
    const int gw = c.bid * 8 + c.wave, NGW = c.G * 8;
    unsigned char* XN8 = c.ws + WS_XN;
    f32x4 cur[8], nxt[8];
    if (gw < MR) row_load(cur, h_row(c, main, gw), c.lane);
    for (int row = gw; row < MP; row += NGW) {
        const int nrow = row + NGW;
        if (nrow < MR) row_load(nxt, h_row(c, main, nrow), c.lane);
        if (row < MR) rms_regs_f8(cur, g, XN8 + (size_t)row * D, c.lane);
        else { v4u z = {0u, 0u, 0u, 0u}; v4u* o = (v4u*)(XN8 + (size_t)row * D); for (int j = 0; j < 2; ++j) o[c.lane + 64 * j] = z; }
#pragma unroll
        for (int j = 0; j < 8; ++j) cur[j] = nxt[j];
    }
}
__device__ __forceinline__ void norm_phase(const Ctx& c, const float* main, const float* g) {
    const int gw = c.bid * 8 + c.wave, NGW = c.G * 8;
    bf16* XN = (bf16*)(c.ws + WS_XN);
    f32x4 cur[8], nxt[8];
    if (gw < MR) row_load(cur, h_row(c, main, gw), c.lane);
    for (int row = gw; row < MP; row += NGW) {
        const int nrow = row + NGW;
        if (nrow < MR) row_load(nxt, h_row(c, main, nrow), c.lane);
        if (row < MR) rms_regs_bf16(cur, g, XN + (size_t)row * D, c.lane);
        else { v4u z = {0u, 0u, 0u, 0u}; v4u* o = (v4u*)(XN + (size_t)row * D); for (int j = 0; j < 4; ++j) o[c.lane + 64 * j] = z; }
#pragma unroll
        for (int j = 0; j < 8; ++j) cur[j] = nxt[j];
    }
}

__device__ __forceinline__ void ph_pre(const Ctx& c) {
    LAS float* scr = (LAS float*)(c.lds + c.wave * 16640);
    const int gw = c.bid * 8 + c.wave, NGW = c.G * 8;
    {
        int base = 0;
        for (int j = 0; j < 15; ++j) { if (j == 0 || j == 10 || j == 11 || j == 13) continue;
            const TJob t = job_l0(c, j); const int ni = t.nsg * (t.K / 64);
            int first = gw - (base % NGW); if (first < 0) first += NGW;
            for (int it = first; it < ni; it += NGW) run_job_item(t, it, scr, c.lane);
            base += ni; }
    }
    { float* hm = (float*)(c.ws + WS_HMPAD); const float* meta = c.in[I_META];
      for (int i = c.bid * 512 + c.tid; i < 256 * D; i += c.G * 512) hm[i] = i < NMETA * D ? meta[i] : 0.f; }
    { float* rt = (float*)(c.ws + WS_ROPE);
      for (int i = c.bid * 512 + c.tid; i < TT * 16; i += c.G * 512) { const int t = i >> 4, j = i & 15;
          const float fr = (float)exp(-(double)j * (1.0 / 16.0) * 13.122363377404328  );
          const float ang = (float)t * fr; const float cv = (float)cos((double)ang), sv = (float)sin((double)ang); rt[2 * i] = cv; rt[2 * i + 1] = sv;
          if ((j & 1) == 0) { float* r8 = rt + (size_t)TT * 32 + (size_t)t * 16 + (j >> 1) * 2; r8[0] = cv; r8[1] = sv; } } }
    { unsigned char* XN8 = c.ws + WS_XN; float* XS = (float*)(c.ws + WS_XS); const float* g = c.in[I_ABNORM]; const float* xin = c.in[I_X]; const float* meta = c.in[I_META];
      f32x4 cur[8], nxt[8];
      if (gw < MR) row_load(cur, gw < MS ? xin + (size_t)gw * D : meta + (size_t)(gw - MS) * D, c.lane);
      for (int row = gw; row < MP; row += NGW) {
          const int nrow = row + NGW;
          if (nrow < MR) row_load(nxt, nrow < MS ? xin + (size_t)nrow * D : meta + (size_t)(nrow - MS) * D, c.lane);
          if (row < MR) rms_regs_i8(cur, g, XN8 + (size_t)row * D, XS + row, c.lane);
          else { v4u z = {0u, 0u, 0u, 0u}; v4u* o = (v4u*)(XN8 + (size_t)row * D); for (int j = 0; j < 2; ++j) o[c.lane + 64 * j] = z; if (c.lane == 0) XS[row] = 1.0f; }
#pragma unroll
          for (int j = 0; j < 8; ++j) cur[j] = nxt[j]; } }
    ph_colmax(c);
}
__device__ __forceinline__ void ph_moecvt(const Ctx& c) {
    LAS float* scr = (LAS float*)(c.lds + c.wave * 18432);
    const int gw = c.bid * 8 + c.wave, NGW = c.G * 8;
    for (int it = gw; it < 24 * 3584; it += NGW) { const TJob t = job_moe(c, it / 3584); run_job_item(t, it % 3584, scr, c.lane); }
}

__device__ __forceinline__ void ph_conv(const Ctx& c) {
    const bf16* Z0 = (const bf16*)(c.ws + WS_Z0); bf16* XC = (bf16*)(c.ws + WS_XC);
    const float* cw = c.in[I_CONVW]; const float* cb = c.in[I_CONVB];
    const int c8 = ((c.bid * 512 + c.tid) & 127) * 8;
    float wk[4][8], bk[8];
#pragma unroll
    for (int k = 0; k < 8; ++k) { bk[k] = cb[c8 + k];
#pragma unroll
        for (int j = 0; j < 4; ++j) wk[j][k] = cw[j * 1024 + c8 + k]; }
    const int S = c.G * 512;
    for (int it0 = c.bid * 512 + c.tid; it0 < MP * 128; it0 += 4 * S) {
        v4u xv[4][4]; int rw[4];
#pragma unroll
        for (int q = 0; q < 4; ++q) { const int it = it0 + q * S; const int row = it >> 7; rw[q] = it < MP * 128 ? row : -1;
            int t = 0, b = 0; if (row < MS) { b = row >> 14; t = NMETA + (row & (SEQ - 1)); } else { b = 0; t = row - MS; }
#pragma unroll
            for (int j = 0; j < 4; ++j) { const int tp = t - 3 + j; xv[q][j] = (v4u){0u, 0u, 0u, 0u}; if (rw[q] >= 0 && row < MR && tp >= 0) xv[q][j] = *(const v4u*)(Z0 + (size_t)row_of(b, tp) * NABP + c8); } }
#pragma unroll
        for (int q = 0; q < 4; ++q) { const int row = rw[q];
            if (row >= 0) {
                float o[8];
                if (row >= MR) { for (int k = 0; k < 8; ++k) o[k] = 0.f; }
                else {
                    for (int k = 0; k < 8; ++k) o[k] = bk[k];
#pragma unroll
                    for (int j = 0; j < 4; ++j) { const unsigned xs[4] = {xv[q][j].x, xv[q][j].y, xv[q][j].z, xv[q][j].w};
#pragma unroll
                        for (int k = 0; k < 4; ++k) { o[2 * k] += wk[j][2 * k] * __builtin_bit_cast(float, xs[k] << 16); o[2 * k + 1] += wk[j][2 * k + 1] * __builtin_bit_cast(float, xs[k] & 0xffff0000u); } }
                }
                v4u w; w.x = pk2(o[0], o[1]); w.y = pk2(o[2], o[3]); w.z = pk2(o[4], o[5]); w.w = pk2(o[6], o[7]);
                *(v4u*)(XC + (size_t)row * 1024 + c8) = w; } }
    }
}
struct LruCh { float br, bi, sp; int colr; };
__device__ __forceinline__ void lru_step(const bf16* RI, const bf16* XC, const LruCh& k, int row, int ch, float& a, float& u) {
    const float rp = bf2f(RI[(size_t)row * D + k.colr]) + k.br, ip = bf2f(RI[(size_t)row * D + k.colr + 256]) + k.bi, xc = bf2f(XC[(size_t)row * 1024 + ch]);
    const float r = sigmoidf_(rp), ig = sigmoidf_(ip), la = -8.0f * r * k.sp;
    a = __expf(la); u = __builtin_amdgcn_sqrtf(fmaxf(1.0f - a * a, 0.f)) * ig * xc;
}
__device__ __forceinline__ LruCh lru_ch(const Ctx& c, int ch) {
    LruCh k; k.br = c.in[I_BR][ch]; k.bi = c.in[I_BI][ch]; const float lam = c.in[I_LAM][ch];
    k.sp = (lam > 0.f ? 0.f : -lam) + log1pf(expf(-fabsf(lam)));
    k.colr = (ch >> 8) * 512 + (ch & 255); return k;
}
__device__ __forceinline__ void ph_scan_a(const Ctx& c) {
    const bf16* RI = (const bf16*)(c.ws + WS_RI); const bf16* XC = (const bf16*)(c.ws + WS_XC);
    float* SA = (float*)(c.ws + WS_LSUM); float* SH = SA + 129 * 1024;
    for (int it = c.bid * 512 + c.tid; it < 129 * 1024; it += c.G * 512) {
        const int chunk = it >> 10, ch = it & 1023; const LruCh k = lru_ch(c, ch);
        const int r0 = chunk < 128 ? chunk * 256 : MS, nr = chunk < 128 ? 256 : NMETA;
        float h = 0.f, A = 1.f;
        for (int i0 = 0; i0 < nr; i0 += 16) { float a[16], u[16];
#pragma unroll
            for (int q = 0; q < 16; ++q) lru_step(RI, XC, k, r0 + i0 + q, ch, a[q], u[q]);
#pragma unroll
            for (int q = 0; q < 16; ++q) { h = a[q] * h + u[q]; A *= a[q]; } }
        SA[it] = A; SH[it] = h;
    }
}
__device__ __forceinline__ void ph_scan_c(const Ctx& c) {
    const bf16* RI = (const bf16*)(c.ws + WS_RI); const bf16* XC = (const bf16*)(c.ws + WS_XC); const bf16* Z0 = (const bf16*)(c.ws + WS_Z0);
    bf16* MIX = (bf16*)(c.ws + WS_MIX);
    const float* SA = (const float*)(c.ws + WS_LSUM); const float* SH = SA + 129 * 1024;
    for (int it = c.bid * 512 + c.tid; it < 129 * 1024; it += c.G * 512) {
        const int chunk = it >> 10, ch = it & 1023; const LruCh k = lru_ch(c, ch);
        const int r0 = chunk < 128 ? chunk * 256 : MS, nr = chunk < 128 ? 256 : NMETA;
        float h = 0.f;
        if (chunk < 128) { const int b = chunk >> 6, j = chunk & 63; h = SH[128 * 1024 + ch];
            for (int jj = 0; jj < j; jj += 16) { float sa[16], sh[16];
#pragma unroll
                for (int q = 0; q < 16; ++q) { const int j2 = jj + q < j ? jj + q : j - 1; const int cc = (b * 64 + j2) * 1024 + ch; sa[q] = SA[cc]; sh[q] = SH[cc]; }
#pragma unroll
                for (int q = 0; q < 16; ++q) if (jj + q < j) h = sa[q] * h + sh[q]; } }
        for (int i0 = 0; i0 < nr; i0 += 16) { float a[16], u[16], yb[16];
#pragma unroll
            for (int q = 0; q < 16; ++q) { lru_step(RI, XC, k, r0 + i0 + q, ch, a[q], u[q]); yb[q] = bf2f(Z0[(size_t)(r0 + i0 + q) * NABP + 1024 + ch]); }
#pragma unroll
            for (int q = 0; q < 16; ++q) { h = a[q] * h + u[q]; const float mv = h * gelu_tanh(yb[q]);
                if (G3_F8) ((unsigned char*)MIX)[(size_t)(r0 + i0 + q) * D + ch] = (unsigned char)f8x4(mv, 0.f, 0.f, 0.f); else MIX[(size_t)(r0 + i0 + q) * D + ch] = (bf16)f2bf(mv); } }
    }
}

struct GlaUnit { int row0, ntok, h, su; };
__device__ __forceinline__ GlaUnit gla_unit(int u) {
    GlaUnit g; if (u < 4) { g.row0 = MS; g.ntok = NMETA; g.h = u; g.su = -1; }
    else { const int v = u - 4, b = v >> 10, c1 = (v & 1023) >> 2; g.h = v & 3; g.row0 = b * SEQ + 64 * c1; g.ntok = 64; g.su = v; }
    return g;
}
__device__ __forceinline__ void ph_gla0(const Ctx& c) {
    const bf16* Z0 = (const bf16*)(c.ws + WS_Z0);
    bf16* QD = (bf16*)(c.ws + WS_QDG); bf16* KD = (bf16*)(c.ws + WS_KDG); bf16* KDT = (bf16*)(c.ws + WS_KDTG); bf16* VT = (bf16*)(c.ws + WS_VTG); float* DEC = (float*)(c.ws + WS_DEC);
    const float* wgk = c.in[I_WGK]; const float* bgk = c.in[I_BGK];
    const int gw = c.bid * 8 + c.wave, NGW = c.G * 8, lane = c.lane;
    for (int it = gw; it < GLA_UNITS * 6; it += NGW) {
        const int u = it / 6, slot = it - 6 * u; const GlaUnit g = gla_unit(u);
        if (slot < 2) {
            const int dk = 64 * slot + lane, col = g.h * 128 + dk;
            float w[16];
#pragma unroll
            for (int r = 0; r < 16; ++r) w[r] = wgk[r * 512 + col];
            const float bias = bgk[col];
            LAS float* gl = (LAS float*)(c.lds + c.wave * 4096);
            { v4u ga = (v4u){0u, 0u, 0u, 0u}, gb = ga;
              if (lane < g.ntok) { const bf16* zr = Z0 + (size_t)(g.row0 + lane) * NABP; ga = *(const v4u*)(zr + 5120); gb = *(const v4u*)(zr + 5128); }
              float f[16]; { float t0[8], t1[8]; unpack8(t0, ga); unpack8(t1, gb);
#pragma unroll
                  for (int r = 0; r < 8; ++r) { f[r] = t0[r]; f[8 + r] = t1[r]; } }
#pragma unroll
              for (int q4 = 0; q4 < 4; ++q4) *(LAS f32x4*)(gl + lane * 16 + 4 * q4) = (f32x4){f[4 * q4], f[4 * q4 + 1], f[4 * q4 + 2], f[4 * q4 + 3]}; }
            LDS_WAIT();
            float bc = 0.f;
            for (int t8 = 0; t8 < 64; t8 += 8) {
                unsigned pk[4];
                if (t8 < g.ntok) {
                    unsigned short qv[8], kv[8];
#pragma unroll
                    for (int i = 0; i < 8; ++i) { const bf16* zr = Z0 + (size_t)(g.row0 + t8 + i) * NABP; qv[i] = zr[2048 + col]; kv[i] = zr[2560 + col]; }
                    float kd[8];
#pragma unroll
                    for (int i = 0; i < 8; ++i) { float x = bias;
#pragma unroll
                        for (int q4 = 0; q4 < 4; ++q4) { const f32x4 gv = *(const LAS f32x4*)(gl + (t8 + i) * 16 + 4 * q4); x += gv.x * w[4 * q4] + gv.y * w[4 * q4 + 1] + gv.z * w[4 * q4 + 2] + gv.w * w[4 * q4 + 3]; }
                        bc += (fminf(x, 0.f) - __logf(1.0f + __expf(-fabsf(x)))) * (1.0f / 16.0f);
                        const size_t ro = (size_t)(g.row0 + t8 + i) * 512 + col;
                        QD[ro] = (bf16)f2bf(bf2f(qv[i]) * __expf(bc) * 0.08838834764831845f);
                        kd[i] = bf2f(kv[i]) * __expf(-bc); KD[ro] = (bf16)f2bf(kd[i]); }
#pragma unroll
                    for (int i = 0; i < 4; ++i) pk[i] = pk2(kd[2 * i], kd[2 * i + 1]);
                } else { pk[0] = pk[1] = pk[2] = pk[3] = 0u; }
                v4u o; o.x = pk[0]; o.y = pk[1]; o.z = pk[2]; o.w = pk[3];
                *(v4u*)(KDT + ((size_t)u * 128 + dk) * 64 + t8) = o;
            }
            LDS_WAIT();
            DEC[(size_t)u * 128 + dk] = __expf(bc);
        } else {
            const int dv = 64 * (slot - 2) + lane, col = 3072 + g.h * 256 + dv;
            for (int t8 = 0; t8 < 64; t8 += 8) {
                unsigned short vv[8];
#pragma unroll
                for (int i = 0; i < 8; ++i) vv[i] = (t8 < g.ntok) ? Z0[(size_t)(g.row0 + t8 + i) * NABP + col] : (unsigned short)0;
                v4u o; o.x = (unsigned)vv[0] | ((unsigned)vv[1] << 16); o.y = (unsigned)vv[2] | ((unsigned)vv[3] << 16); o.z = (unsigned)vv[4] | ((unsigned)vv[5] << 16); o.w = (unsigned)vv[6] | ((unsigned)vv[7] << 16);
                *(v4u*)(VT + ((size_t)u * 256 + dv) * 64 + t8) = o;
            }
        }
    }
}
__device__ __forceinline__ void ph_gla1(const Ctx& c) {
    const bf16* KDT = (const bf16*)(c.ws + WS_KDTG); const bf16* VT = (const bf16*)(c.ws + WS_VTG); bf16* DST = (bf16*)(c.ws + WS_DST);
    const int lane = c.lane, g4 = lane >> 4, l15 = lane & 15;
    const int gw = c.bid * 8 + c.wave, NGW = c.G * 8;
    for (int it = gw; it < GLA_UNITS * 8; it += NGW) {
        const int u = it >> 3, w = it & 7;
        bf16x8 af[2][2], bfr[8][2];
#pragma unroll
        for (int ks = 0; ks < 2; ++ks) {
#pragma unroll
            for (int a = 0; a < 2; ++a) af[a][ks] = *(const bf16x8*)(VT + ((size_t)u * 256 + (2 * w + a) * 16 + l15) * 64 + ks * 32 + 8 * g4);
#pragma unroll
            for (int b = 0; b < 8; ++b) bfr[b][ks] = *(const bf16x8*)(KDT + ((size_t)u * 128 + b * 16 + l15) * 64 + ks * 32 + 8 * g4); }
        f32x4 acc[2][8];
#pragma unroll
        for (int a = 0; a < 2; ++a)
#pragma unroll
            for (int b = 0; b < 8; ++b) { acc[a][b] = (f32x4){0.f, 0.f, 0.f, 0.f};
#pragma unroll
                for (int ks = 0; ks < 2; ++ks) acc[a][b] = __builtin_amdgcn_mfma_f32_16x16x32_bf16(bfr[b][ks], af[a][ks], acc[a][b], 0, 0, 0); }
        bf16* dst = DST + (size_t)u * 32768;
#pragma unroll
        for (int a = 0; a < 2; ++a)
#pragma unroll
            for (int b = 0; b < 8; ++b) { v2u o; o.x = pk2(acc[a][b][0], acc[a][b][1]); o.y = pk2(acc[a][b][2], acc[a][b][3]);
                *(v2u*)(dst + ((2 * w + a) * 16 + l15) * 128 + b * 16 + 4 * g4) = o; }
    }
}
__device__ __forceinline__ void ph_gla2(const Ctx& c) {
    const bf16* DST = (const bf16*)(c.ws + WS_DST); const float* DEC = (const float*)(c.ws + WS_DEC); bf16* ST = (bf16*)(c.ws + WS_ST);
    const int gw = c.bid * 8 + c.wave, NGW = c.G * 8;
    for (int it = gw; it < 2048; it += NGW) {
        const int b = it >> 10, h = (it >> 8) & 3, dv = it & 255;
        const unsigned s0 = *(const unsigned*)(DST + (size_t)h * 32768 + dv * 128 + 2 * c.lane);
        f32x2 S = (f32x2){__builtin_bit_cast(float, s0 << 16), __builtin_bit_cast(float, s0 & 0xffff0000u)} * *(const f32x2*)(DEC + (size_t)h * 128 + 2 * c.lane);
        for (int c0 = 0; c0 < 256; c0 += 16) {
            unsigned dsb[16]; f32x2 de[16];
#pragma unroll
            for (int k = 0; k < 16; ++k) { const size_t u = 4 + (size_t)b * 1024 + (size_t)(c0 + k) * 4 + h;
                dsb[k] = *(const unsigned*)(DST + u * 32768 + dv * 128 + 2 * c.lane); de[k] = *(const f32x2*)(DEC + u * 128 + 2 * c.lane); }
#pragma unroll
            for (int k = 0; k < 16; ++k) { const size_t su = (size_t)b * 1024 + (size_t)(c0 + k) * 4 + h;
                *(unsigned*)(ST + su * 32768 + dv * 128 + 2 * c.lane) = pk2(S.x, S.y);
                S = de[k] * (S + (f32x2){__builtin_bit_cast(float, dsb[k] << 16), __builtin_bit_cast(float, dsb[k] & 0xffff0000u)}); }
        }
    }
}
constexpr int GL_ATT = 0, GL_SSQ = 9216, GL_RST = 9216 + 2048;
__device__ __forceinline__ void ph_gla3(const Ctx& c) {
    const bf16* Z0 = (const bf16*)(c.ws + WS_Z0); const bf16* ST = (const bf16*)(c.ws + WS_ST); bf16* MIX = (bf16*)(c.ws + WS_MIX);
    const bf16* QD = (const bf16*)(c.ws + WS_QDG); const bf16* KD = (const bf16*)(c.ws + WS_KDG); const bf16* VT = (const bf16*)(c.ws + WS_VTG);
    LAS bf16* att = (LAS bf16*)(c.lds + GL_ATT); LAS float* ssq = (LAS float*)(c.lds + GL_SSQ); LAS float* rst = (LAS float*)(c.lds + GL_RST);
    const int lane = c.lane, g4 = lane >> 4, l15 = lane & 15, w = c.wave;
    const float* gnorm = c.in[I_GLANORM];
    for (int u = c.bid; u < GLA_UNITS; u += c.G) {
        const GlaUnit g = gla_unit(u);
        const bf16* qd = QD + (size_t)g.row0 * 512 + g.h * 128; const bf16* kd = KD + (size_t)g.row0 * 512 + g.h * 128;
        {
            const int ti = w >> 1;
            bf16x8 af[4];
#pragma unroll
            for (int ks = 0; ks < 4; ++ks) af[ks] = *(const bf16x8*)(qd + (size_t)(ti * 16 + l15) * 512 + ks * 32 + 8 * g4);
#pragma unroll
            for (int q = 0; q < 2; ++q) { const int sj = 2 * (w & 1) + q; f32x4 a = (f32x4){0.f, 0.f, 0.f, 0.f};
                if (sj <= ti) {
                    bf16x8 bfr[4];
#pragma unroll
                    for (int ks = 0; ks < 4; ++ks) bfr[ks] = *(const bf16x8*)(kd + (size_t)(sj * 16 + l15) * 512 + ks * 32 + 8 * g4);
#pragma unroll
                    for (int ks = 0; ks < 4; ++ks) a = __builtin_amdgcn_mfma_f32_16x16x32_bf16(af[ks], bfr[ks], a, 0, 0, 0); }
#pragma unroll
                for (int j = 0; j < 4; ++j) { const int t = ti * 16 + 4 * g4 + j, s2 = sj * 16 + l15; att[t * 72 + s2] = (bf16)f2bf((s2 <= t && t < g.ntok) ? a[j] : 0.f); } }
        }
        __syncthreads();
        f32x4 acc[4][2];
#pragma unroll
        for (int ti = 0; ti < 4; ++ti)
#pragma unroll
            for (int n = 0; n < 2; ++n) acc[ti][n] = (f32x4){0.f, 0.f, 0.f, 0.f};
        if (g.su >= 0) {
            const bf16* st = ST + (size_t)g.su * 32768;
#pragma unroll
            for (int ks = 0; ks < 4; ++ks) { bf16x8 bfr[2], afr[4];
#pragma unroll
                for (int n = 0; n < 2; ++n) bfr[n] = *(const bf16x8*)(st + (size_t)(32 * w + 16 * n + l15) * 128 + ks * 32 + 8 * g4);
#pragma unroll
                for (int ti = 0; ti < 4; ++ti) afr[ti] = *(const bf16x8*)(qd + (size_t)(ti * 16 + l15) * 512 + ks * 32 + 8 * g4);
#pragma unroll
                for (int ti = 0; ti < 4; ++ti)
#pragma unroll
                    for (int n = 0; n < 2; ++n) acc[ti][n] = __builtin_amdgcn_mfma_f32_16x16x32_bf16(afr[ti], bfr[n], acc[ti][n], 0, 0, 0); }
        }
#pragma unroll
        for (int ks = 0; ks < 2; ++ks) { bf16x8 bfr[2];
#pragma unroll
            for (int n = 0; n < 2; ++n) bfr[n] = *(const bf16x8*)(VT + ((size_t)u * 256 + 32 * w + 16 * n + l15) * 64 + ks * 32 + 8 * g4);
#pragma unroll
            for (int ti = 0; ti < 4; ++ti) { const bf16x8 af = *(const LAS bf16x8*)(att + (ti * 16 + l15) * 72 + ks * 32 + 8 * g4);
#pragma unroll
                for (int n = 0; n < 2; ++n) acc[ti][n] = __builtin_amdgcn_mfma_f32_16x16x32_bf16(af, bfr[n], acc[ti][n], 0, 0, 0); } }
        LAS float* OT = (LAS float*)(c.lds + 16384);
#pragma unroll
        for (int ti = 0; ti < 4; ++ti)
#pragma unroll
            for (int j = 0; j < 4; ++j) { float p = acc[ti][0][j] * acc[ti][0][j] + acc[ti][1][j] * acc[ti][1][j];
                p = row_sum16(p);
                if (l15 == 0) ssq[w * 64 + ti * 16 + 4 * g4 + j] = p;
#pragma unroll
                for (int n = 0; n < 2; ++n) OT[(ti * 16 + 4 * g4 + j) * 260 + 32 * w + 16 * n + l15] = acc[ti][n][j]; }
        __syncthreads();
        if (c.tid < 64) { float s2 = 0.f; for (int k = 0; k < 8; ++k) s2 += ssq[k * 64 + c.tid]; rst[c.tid] = 1.0f / sqrtf(s2 * (1.f / 256.f) + EPS); }
        __syncthreads();
        { const int e0 = (c.tid & 31) * 8; const f32x4 gn0 = *(const f32x4*)(gnorm + e0), gn1 = *(const f32x4*)(gnorm + e0 + 4);
#pragma unroll
          for (int k = 0; k < 4; ++k) { const int t = (c.tid >> 5) + 16 * k;
              if (t < g.ntok) { const float rs = rst[t]; const size_t row = (size_t)(g.row0 + t);
                  const f32x4 o0 = *(const LAS f32x4*)(OT + t * 260 + e0), o1 = *(const LAS f32x4*)(OT + t * 260 + e0 + 4);
                  const v4u gv = *(const v4u*)(Z0 + row * NABP + 4096 + g.h * 256 + e0); const unsigned gs[4] = {gv.x, gv.y, gv.z, gv.w};
                  float y[8];
#pragma unroll
                  for (int q = 0; q < 4; ++q) { const float ga = __builtin_bit_cast(float, gs[q] << 16), gb = __builtin_bit_cast(float, gs[q] & 0xffff0000u);
                      const float oa = q < 2 ? o0[2 * q] : o1[2 * q - 4], ob = q < 2 ? o0[2 * q + 1] : o1[2 * q - 3];
                      const float na = q < 2 ? gn0[2 * q] : gn1[2 * q - 4], nb = q < 2 ? gn0[2 * q + 1] : gn1[2 * q - 3];
                      y[2 * q] = oa * rs * na * siluf_(ga); y[2 * q + 1] = ob * rs * nb * siluf_(gb); }
                  if (G3_F8) { v2u wv; wv.x = f8x4(y[0], y[1], y[2], y[3]); wv.y = f8x4(y[4], y[5], y[6], y[7]); *(v2u*)((unsigned char*)MIX + row * D + 1024 + g.h * 256 + e0) = wv; }
                  else { v4u wv; wv.x = pk2(y[0], y[1]); wv.y = pk2(y[2], y[3]); wv.z = pk2(y[4], y[5]); wv.w = pk2(y[6], y[7]);
                  *(v4u*)(MIX + row * D + 1024 + g.h * 256 + e0) = wv; } } } }
        __syncthreads();
    }
}

__device__ __forceinline__ void rope_chunk(float (&o)[8], const v4u own, const v4u par, const f32x4 (&cs)[4], float sgn) {
    const unsigned a[4] = {own.x, own.y, own.z, own.w}, p[4] = {par.x, par.y, par.z, par.w};
#pragma unroll
    for (int k = 0; k < 4; ++k) { const float a0 = __builtin_bit_cast(float, a[k] << 16), a1 = __builtin_bit_cast(float, a[k] & 0xffff0000u), p0 = __builtin_bit_cast(float, p[k] << 16), p1 = __builtin_bit_cast(float, p[k] & 0xffff0000u);
        o[2 * k] = a0 * cs[k].x + sgn * p0 * cs[k].y; o[2 * k + 1] = a1 * cs[k].z + sgn * p1 * cs[k].w; }
}
__device__ __forceinline__ v2u fp8x8(const float (&o)[8]) {
    unsigned w0 = 0u, w1 = 0u;
    w0 = __builtin_amdgcn_cvt_pk_fp8_f32(o[0], o[1], w0, false); w0 = __builtin_amdgcn_cvt_pk_fp8_f32(o[2], o[3], w0, true);
    w1 = __builtin_amdgcn_cvt_pk_fp8_f32(o[4], o[5], w1, false); w1 = __builtin_amdgcn_cvt_pk_fp8_f32(o[6], o[7], w1, true);
    v2u w; w.x = w0; w.y = w1; return w;
}
__device__ __forceinline__ v4u bf16x8_pack(const float (&o)[8]) { v4u w; w.x = pk2(o[0], o[1]); w.y = pk2(o[2], o[3]); w.z = pk2(o[4], o[5]); w.w = pk2(o[6], o[7]); return w; }
__device__ __forceinline__ void ph_rope(const Ctx& c) {
    bf16* Z1 = (bf16*)(c.ws + WS_Z1); bf16* KIP = (bf16*)(c.ws + WS_KIP); float* WIS = (float*)(c.ws + WS_WIS); const float* rt = (const float*)(c.ws + WS_ROPE); const float* rt8 = rt + (size_t)TT * 32;
    const int gw = c.bid * 8 + c.wave, NGW = c.G * 8, lane = c.lane;
    const int q_own = (lane >> 2) * 128 + 8 * (lane & 3), q_par = (lane >> 2) * 128 + 8 * ((lane & 3) ^ 2);
    const int k_own = 2048 + 8 * lane, k_par = 2048 + 8 * (lane ^ 2);
    const bool k_rot = (lane & 15) < 4;
    const int il = lane < 24 ? lane : 23;
    const int i_own = il < 16 ? 3072 + (il >> 1) * 64 + 8 * (il & 1) : 3584 + 8 * (il - 16);
    const int i_par = il < 16 ? 3072 + (il >> 1) * 64 + 8 * ((il & 1) ^ 1) : 3584 + 8 * ((il - 16) < 2 ? ((il - 16) ^ 1) : (il - 16));
    const bool i_rot = il < 16 || (il - 16) < 2; const float i_sgn = (il < 16 ? (il & 1) : ((il - 16) & 1)) ? 1.f : -1.f;
    const float qk_sgn = (lane & 2) ? 1.f : -1.f;
#pragma unroll 2
    for (int row = gw; row < MR; row += NGW) {
        const int t = row < MS ? NMETA + (row & (SEQ - 1)) : row - MS;
        bf16* z = Z1 + (size_t)row * NCP;
        const v4u qo = *(const v4u*)(z + q_own), qp = *(const v4u*)(z + q_par), ko = *(const v4u*)(z + k_own), kp = *(const v4u*)(z + k_par), vo = *(const v4u*)(z + 2560 + 8 * lane);
        const v4u io = *(const v4u*)(z + i_own), ip = *(const v4u*)(z + i_par);
        const float wv = bf2f(z[3648 + (lane & 7)]);
        f32x4 cs[4], cs8[4]; const f32x4* tp = (const f32x4*)(rt + (size_t)t * 32 + 16 * (lane & 1)); const f32x4* tp8 = (const f32x4*)(rt8 + (size_t)t * 16);
#pragma unroll
        for (int k = 0; k < 4; ++k) { cs[k] = tp[k]; cs8[k] = tp8[k]; }
        float o[8];
        rope_chunk(o, qo, qp, cs, qk_sgn); *(v4u*)(z + q_own) = bf16x8_pack(o);
        if (k_rot) rope_chunk(o, ko, kp, cs, qk_sgn); else unpack8(o, ko);
        *(v2u*)(c.ws + WS_K8 + (size_t)row * 512 + 8 * lane) = fp8x8(o);
        unpack8(o, vo); *(v2u*)(c.ws + WS_V8 + (size_t)row * 512 + 8 * lane) = fp8x8(o);
        v4u iv = io;
        if (i_rot) { rope_chunk(o, io, ip, cs8, i_sgn); iv = bf16x8_pack(o); }
        if (lane < 16) *(v4u*)(z + i_own) = iv;
        else if (lane < 24) { const int ch = lane - 16;
            if (row < MS) *(v4u*)(KIP + (size_t)(row >> 14) * KIP_STRIDE * 64 + kip_off(t, ch)) = iv;
            else { *(v4u*)(KIP + kip_off(t, ch)) = iv; *(v4u*)(KIP + (size_t)KIP_STRIDE * 64 + kip_off(t, ch)) = iv; } }
        else if (lane < 32) WIS[(size_t)row * 8 + (lane - 24)] = wv;
    }
}
constexpr int IX_CAP = 576, IX_KEEP = 240, IX_TRIG = IX_CAP - 64;
__device__ __forceinline__ float relu_(float x) { const int i = __builtin_bit_cast(int, x); return __builtin_bit_cast(float, i > 0 ? i : 0); }
typedef short s2_t __attribute__((ext_vector_type(2)));
constexpr float IX_QS = 1.0f / 512.0f, IX_WS = 1024.0f;
__device__ __forceinline__ unsigned ix_pack(int s, int key) {
    const int k = s < -(1 << 27) ? -(1 << 27) : (s > (1 << 27) - 1 ? (1 << 27) - 1 : s);
    return (((unsigned)(k + (1 << 27)) << 4) & 0xFFFF8000u) | (unsigned)(32767 - key);
}
__device__ __forceinline__ int ix_thr(unsigned v) { return (int)((v >> 15) << 11) - (1 << 27); }
__device__ __forceinline__ unsigned wave_or_u32(unsigned x) {
    x |= (unsigned)__builtin_amdgcn_update_dpp(0, (int)x, 0xB1, 0xf, 0xf, true); x |= (unsigned)__builtin_amdgcn_update_dpp(0, (int)x, 0x4E, 0xf, 0xf, true);
    x |= (unsigned)__builtin_amdgcn_update_dpp(0, (int)x, 0x124, 0xf, 0xf, true); x |= (unsigned)__builtin_amdgcn_update_dpp(0, (int)x, 0x128, 0xf, 0xf, true);
    return (unsigned)__builtin_amdgcn_readlane((int)x, 0) | (unsigned)__builtin_amdgcn_readlane((int)x, 16) | (unsigned)__builtin_amdgcn_readlane((int)x, 32) | (unsigned)__builtin_amdgcn_readlane((int)x, 48);
}
template <bool EXACT>
__device__ __forceinline__ void ix_compact(LAS unsigned* buf, LAS unsigned* cnt, LAS int* tau, int q, int lane, int nmin) {
    LDS_WAIT();
    const int n = (int)cnt[q];
    if (n < nmin) return;
    const int tprev = tau[q];
    unsigned e[9];
#pragma unroll
    for (int i = 0; i < 9; ++i) e[i] = (lane + 64 * i < n) ? buf[q * IX_CAP + lane + 64 * i] : 0u;
    const unsigned orv = wave_or_u32(e[0] | e[1] | e[2] | e[3] | e[4] | e[5] | e[6] | e[7] | e[8]);
    const unsigned vprev = tprev == (int)0x80000000 ? 0u : (((unsigned)(tprev + (1 << 27)) >> 11) << 15);
    const unsigned diff = vprev ^ orv;
    const int top = diff ? 31 - __builtin_clz(diff) : -1;
    unsigned v = top >= 31 ? 0u : (top < 0 ? vprev : (vprev & ~((2u << top) - 1u)));
    int kept = n;
    int lowbit = (EXACT || top < 15) ? 0 : 15;
    for (int bit = top; bit >= lowbit; --bit) { const unsigned cand = v | (1u << bit); int cc = 0;
#pragma unroll
        for (int i = 0; i < 9; ++i) cc += __builtin_popcountll(__ballot(e[i] >= cand));
        if (cc >= IX_KEEP) { v = cand; kept = cc; }
        if (EXACT ? kept == IX_KEEP : kept <= IX_KEEP + 40) break;
        if (!EXACT && bit == 15) lowbit = 0;
    }
    int base = 0;
#pragma unroll
    for (int i = 0; i < 9; ++i) { const bool keep = e[i] >= v; const unsigned long long m = __ballot(keep);
        const int pos = base + (int)__builtin_amdgcn_mbcnt_hi((unsigned)(m >> 32), __builtin_amdgcn_mbcnt_lo((unsigned)m, 0u));
        if (keep) buf[q * IX_CAP + pos] = e[i]; base += __builtin_popcountll(m); }
    if (lane == 0) { cnt[q] = (unsigned)base; tau[q] = ix_thr(v); }
    LDS_WAIT();
}
__device__ __forceinline__ void ix_task(const Ctx& c, int b, int grp) {
    const bf16* Z1 = (const bf16*)(c.ws + WS_Z1); const bf16* KIP = (const bf16*)(c.ws + WS_KIP) + (size_t)b * KIP_STRIDE * 64; const float* WIS = (const float*)(c.ws + WS_WIS);
    unsigned short* SEL = (unsigned short*)(c.ws + WS_SEL); int* SELCNT = (int*)(c.ws + WS_SELCNT);
    LAS unsigned* buf = (LAS unsigned*)c.lds; LAS unsigned* cnt = (LAS unsigned*)(c.lds + 64 * IX_CAP * 4); LAS int* tau = (LAS int*)(c.lds + 64 * IX_CAP * 4 + 256);
    const int lane = c.lane, g4 = lane >> 4, l15 = lane & 15, qs = c.wave * 8;
    const int t0 = NMETA + 8 * grp;
    const int qrow0 = b * SEQ + 8 * grp;
    if (lane < 8) { cnt[qs + lane] = 0u; tau[qs + lane] = (int)0x80000000; }
    bf16x8 af[2][2][2]; s2_t wq[2][4];
#pragma unroll
    for (int qg = 0; qg < 2; ++qg) { const size_t ro = (size_t)(qrow0 + 4 * qg + (l15 >> 2)) * NCP + 3072;
#pragma unroll
        for (int hh = 0; hh < 2; ++hh)
#pragma unroll
            for (int ks = 0; ks < 2; ++ks) af[qg][hh][ks] = *(const bf16x8*)(Z1 + ro + (4 * hh + (l15 & 3)) * 64 + 32 * ks + 8 * g4);
        const float* wp = WIS + (size_t)(qrow0 + 4 * qg + g4) * 8;
#pragma unroll
        for (int h = 0; h < 4; ++h) wq[qg][h] = __builtin_bit_cast(s2_t, __builtin_amdgcn_cvt_pk_i16((int)rintf(wp[2 * h] * IX_WS), (int)rintf(wp[2 * h + 1] * IX_WS))); }
#pragma unroll
    for (int qg = 0; qg < 2; ++qg)
#pragma unroll
        for (int hh = 0; hh < 2; ++hh)
#pragma unroll
            for (int ks = 0; ks < 2; ++ks) { const v4u u = __builtin_bit_cast(v4u, af[qg][hh][ks]); const unsigned uu[4] = {u.x, u.y, u.z, u.w}; unsigned r[4];
#pragma unroll
                for (int q = 0; q < 4; ++q) r[q] = pk2(__builtin_bit_cast(float, uu[q] << 16) * IX_QS, __builtin_bit_cast(float, uu[q] & 0xffff0000u) * IX_QS);
                v4u o; o.x = r[0]; o.y = r[1]; o.z = r[2]; o.w = r[3]; af[qg][hh][ks] = __builtin_bit_cast(bf16x8, o); }
    int th[2] = {(int)0x80000000, (int)0x80000000};
    int cq[2] = {0, 0};
    const unsigned ltmask = (1u << l15) - 1u;
    const int qb0 = (qs + g4) * IX_CAP, qb1 = (qs + 4 + g4) * IX_CAP;
    LDS_WAIT();
#ifdef IX_PROBE_TWICE
    for (int rep_ = 0; rep_ < 2; ++rep_) { th[0] = th[1] = rep_ == 0 ? 0x7fffffff : (int)0x80000000;
#endif
    bf16x8 kr0[4][2], kr1[4][2];
    const int NI = (t0 + 7 - NMETA) / 128 + 1, NU = t0 >= 143 ? (t0 - 143) / 128 + 1 : 0;
    const int rot = NU > 0 ? (int)(((unsigned)(c.bid >> 3) * (unsigned)NU) >> 5) : 0;
    int kb0 = NMETA + 128 * (NU > 0 ? rot : 0);
    asm volatile("" :: "v"(af[0][0][0]), "v"(af[0][0][1]), "v"(af[0][1][0]), "v"(af[0][1][1]), "v"(af[1][0][0]), "v"(af[1][0][1]), "v"(af[1][1][0]), "v"(af[1][1][1]));
    asm volatile("" :: "v"(wq[0][0]), "v"(wq[0][1]), "v"(wq[0][2]), "v"(wq[0][3]), "v"(wq[1][0]), "v"(wq[1][1]), "v"(wq[1][2]), "v"(wq[1][3]));
#pragma unroll
    for (int tl = 0; tl < 4; ++tl) {
#pragma unroll
        for (int ks = 0; ks < 2; ++ks) kr0[tl][ks] = *(const bf16x8*)(KIP + ((size_t)((kb0 >> 4) + tl) * 128 + 64 * ks + lane) * 8);
        asm volatile("" ::: "memory"); }
#pragma unroll
    for (int tl = 0; tl < 4; ++tl) {
#pragma unroll
        for (int ks = 0; ks < 2; ++ks) kr1[tl][ks] = *(const bf16x8*)(KIP + ((size_t)((kb0 >> 4) + 4 + tl) * 128 + 64 * ks + lane) * 8);
        asm volatile("" ::: "memory"); }
    const int klim0 = t0 + g4, klim1 = t0 + 4 + g4;
    const int ixdummy = 64 * IX_CAP + 128 + lane;
#define IX_BLOCK(CB, KB0, KBN, MASKED) { \
        _Pragma("unroll") \
        for (int tl = 0; tl < 4; ++tl) { \
            const int key = (KB0) + 16 * tl + l15; \
            f32x4 dd[2][2]; \
            _Pragma("unroll") \
            for (int qg = 0; qg < 2; ++qg) { dd[qg][0] = (f32x4){0.f, 0.f, 0.f, 0.f}; dd[qg][1] = dd[qg][0]; \
                _Pragma("unroll") \
                for (int ks = 0; ks < 2; ++ks) { dd[qg][0] = __builtin_amdgcn_mfma_f32_16x16x32_bf16(af[qg][0][ks], CB[tl][ks], dd[qg][0], 0, 0, 0); dd[qg][1] = __builtin_amdgcn_mfma_f32_16x16x32_bf16(af[qg][1][ks], CB[tl][ks], dd[qg][1], 0, 0, 0); } } \
            _Pragma("unroll") \
            for (int ks = 0; ks < 2; ++ks) CB[tl][ks] = *(const bf16x8*)(KIP + ((size_t)(((KBN) >> 4) + tl) * 128 + 64 * ks + lane) * 8); \
            if (IX_LIGHT) { asm volatile("" :: "v"(dd[0][0]), "v"(dd[0][1]), "v"(dd[1][0]), "v"(dd[1][1])); } else \
            _Pragma("unroll") \
            for (int qg = 0; qg < 2; ++qg) { const f32x4 d0 = dd[qg][0], d1 = dd[qg][1]; \
                int sv = 0;        \
                sv = __builtin_amdgcn_sdot2(__builtin_bit_cast(s2_t, __builtin_amdgcn_cvt_pknorm_u16(d0[0], d0[1])), wq[qg][0], sv, false); \
                sv = __builtin_amdgcn_sdot2(__builtin_bit_cast(s2_t, __builtin_amdgcn_cvt_pknorm_u16(d0[2], d0[3])), wq[qg][1], sv, false); \
                sv = __builtin_amdgcn_sdot2(__builtin_bit_cast(s2_t, __builtin_amdgcn_cvt_pknorm_u16(d1[0], d1[1])), wq[qg][2], sv, false); \
                sv = __builtin_amdgcn_sdot2(__builtin_bit_cast(s2_t, __builtin_amdgcn_cvt_pknorm_u16(d1[2], d1[3])), wq[qg][3], sv, false); \
                  \
                  \
                const bool ps = MASKED ? ((sv > th[qg]) & (key <= (qg ? klim1 : klim0))) : (sv > th[qg]); \
                const unsigned long long m = __builtin_amdgcn_ballot_w64(ps); \
                const unsigned half = g4 >= 2 ? (unsigned)(m >> 32) : (unsigned)m; \
                const unsigned field = (half >> (16 * (g4 & 1))) & 0xFFFFu; \
                const int pos = cq[qg] + __builtin_popcount(field & ltmask); \
                buf[ps ? (qg ? qb1 : qb0) + pos : ixdummy] = ix_pack(sv, key); \
                cq[qg] += __builtin_popcount(field); \
            } \
        } \
        if (__any(cq[0] >= IX_TRIG || cq[1] >= IX_TRIG)) { \
            if (l15 == 0) { cnt[qs + g4] = (unsigned)cq[0]; cnt[qs + 4 + g4] = (unsigned)cq[1]; } \
            LDS_WAIT(); \
            for (int i = 0; i < 8; ++i) ix_compact<false>(buf, cnt, tau, qs + i, lane, IX_TRIG); \
            LDS_WAIT(); \
            th[0] = tau[qs + g4]; th[1] = tau[qs + 4 + g4]; cq[0] = (int)cnt[qs + g4]; cq[1] = (int)cnt[qs + 4 + g4]; \
        } }
    int it = 0;
#ifdef IX_PROBE_LIGHT
#define IX_LIGHT 1
    if (rep_ == 0) {
#pragma unroll 1
    for (; it < NI; ++it) {
        const int kbn = NMETA + 128 * (it + 1);
        IX_BLOCK(kr0, kb0, kbn, false)
        IX_BLOCK(kr1, kb0 + 64, kbn + 64, false)
        kb0 = kbn;
    } }
#undef IX_LIGHT
#endif
#define IX_LIGHT 0
#pragma unroll 1
    for (; it < NU; ++it) {
        int nx = it + 1 + rot; nx = nx >= NU ? nx - NU : nx; if (it + 1 >= NU) nx = it + 1;
#ifdef IX_PROBE_SAMEBLOCK
        const int kbn = rep_ == 0 ? NMETA : NMETA + 128 * nx;
#else
        const int kbn = NMETA + 128 * nx;
#endif
        IX_BLOCK(kr0, kb0, kbn, false)
        IX_BLOCK(kr1, kb0 + 64, kbn + 64, false)
        kb0 = kbn;
    }
#pragma unroll 1
    for (; it < NI; ++it) {
        const int kbn = kb0 + 128;
        IX_BLOCK(kr0, kb0, kbn, true)
        IX_BLOCK(kr1, kb0 + 64, kbn + 64, true)
        kb0 = kbn;
    }
#undef IX_BLOCK
#undef IX_LIGHT
    if (l15 == 0) { cnt[qs + g4] = (unsigned)cq[0]; cnt[qs + 4 + g4] = (unsigned)cq[1]; }
    LDS_WAIT();
#ifdef IX_PROBE_TWICE
    }
#endif
    for (int i = 0; i < 8; ++i) {
        ix_compact<true>(buf, cnt, tau, qs + i, lane, IX_KEEP + 1);
        LDS_WAIT();
        const int n = (int)cnt[qs + i];
        for (int j = lane; j < n; j += 64) SEL[(size_t)(qrow0 + i) * IX_KEEP + j] = (unsigned short)(32767u - (buf[(qs + i) * IX_CAP + j] & 0x7FFFu));
        if (lane == 0) SELCNT[qrow0 + i] = n;
    }
    LDS_WAIT();
}
__device__ __forceinline__ void ph_index(const Ctx& c) {
    const int gw = c.bid * 8 + c.wave, NGW = c.G * 8;
    for (int p = gw; p < 2048; p += NGW) { ix_task(c, 0, 2047 - p); ix_task(c, 1, p); }
}
__device__ __forceinline__ unsigned pk_fp8x4(unsigned lo2, unsigned hi2) {
    unsigned w = 0u;
    w = __builtin_amdgcn_cvt_pk_fp8_f32(__builtin_bit_cast(float, lo2 << 16), __builtin_bit_cast(float, lo2 & 0xffff0000u), w, false);
    w = __builtin_amdgcn_cvt_pk_fp8_f32(__builtin_bit_cast(float, hi2 << 16), __builtin_bit_cast(float, hi2 & 0xffff0000u), w, true);
    return w;
}
__device__ __forceinline__ void ph_attn(const Ctx& c) {
    const bf16* Z1 = (const bf16*)(c.ws + WS_Z1); const unsigned short* SEL = (const unsigned short*)(c.ws + WS_SEL); const int* SELCNT = (const int*)(c.ws + WS_SELCNT);
    bf16* ATT = (bf16*)(c.ws + WS_ATT); const unsigned char* K8 = c.ws + WS_K8; const unsigned char* V8 = c.ws + WS_V8;
    LAS int* rows = (LAS int*)(c.lds + c.wave * 14336); LAS float* P = (LAS float*)(c.lds + c.wave * 14336 + 1024);
    LAS unsigned char* Vs = c.lds + c.wave * 14336 + 5120;
    LAS unsigned char* P8 = (LAS unsigned char*)P;
    const int lane = c.lane, g4 = lane >> 4, l15 = lane & 15, rsub = lane >> 3, dseg = lane & 7;
    const int cls = c.bid & 7, b = cls >> 2, g = cls & 3;
    const int rank = (c.bid >> 3) * 8 + c.wave, nrank = (c.G >> 3) * 8;
    for (int t = rank; t < TT; t += nrank) {
        if (b == 1 && t < NMETA) continue;
        const int qrow = row_of(b, t);
        const bf16* qp0 = Z1 + (size_t)qrow * NCP + (4 * g + (l15 < 4 ? l15 : 0)) * 128 + 16 * g4;
        const v4u xa = *(const v4u*)qp0, xb = *(const v4u*)(qp0 + 8), xc = *(const v4u*)(qp0 + 64), xd = *(const v4u*)(qp0 + 72);
        int n;
        if (t < NMETA) { n = t + 1; for (int j = lane; j < 256; j += 64) rows[j] = MS + (j < n ? j : 0); }
        else {
            int sj[4];
#pragma unroll
            for (int i = 0; i < 4; ++i) { int jj = lane + 64 * i - NMETA; jj = jj < 0 ? 0 : (jj > IX_KEEP - 1 ? IX_KEEP - 1 : jj); sj[i] = (int)SEL[(size_t)qrow * IX_KEEP + jj]; }
            const int cn = SELCNT[qrow]; n = NMETA + cn;
#pragma unroll
            for (int i = 0; i < 4; ++i) { const int j = lane + 64 * i; int r = MS; if (j < NMETA) r = MS + j; else if (j < n) r = b * SEQ + sj[i] - NMETA; rows[j] = r; } }
        long qf[2][2];
        { const bool qz = l15 >= 4;
          qf[0][0] = qz ? 0l : (long)(((unsigned long long)pk_fp8x4(xa.z, xa.w) << 32) | (unsigned long long)pk_fp8x4(xa.x, xa.y));
          qf[0][1] = qz ? 0l : (long)(((unsigned long long)pk_fp8x4(xb.z, xb.w) << 32) | (unsigned long long)pk_fp8x4(xb.x, xb.y));
          qf[1][0] = qz ? 0l : (long)(((unsigned long long)pk_fp8x4(xc.z, xc.w) << 32) | (unsigned long long)pk_fp8x4(xc.x, xc.y));
          qf[1][1] = qz ? 0l : (long)(((unsigned long long)pk_fp8x4(xd.z, xd.w) << 32) | (unsigned long long)pk_fp8x4(xd.x, xd.y)); }
        LDS_WAIT();
        const int ntile = (n + 15) >> 4;
        const int nchk = (ntile + 3) >> 2;
        const unsigned kcol = (unsigned)(g * 128 + 16 * (lane & 7));
        v4u krA[8], krB[8];
#define AT_KLOAD(VR, CH) do { _Pragma("unroll") for (int i = 0; i < 8; ++i) { const unsigned ko = (unsigned)rows[64 * (CH) + 8 * i + (lane >> 3)] * 512u + kcol; VR[i] = *(const v4u*)(K8 + ko); } } while (0)
#define AT_KSTAGE(VR) do { _Pragma("unroll") for (int i = 0; i < 8; ++i) *(LAS v4u*)(Vs + (8 * i + (lane >> 3)) * 144 + (lane & 7) * 16) = VR[i]; } while (0)
#define AT_QK(CH, LIVE) do { f32x4 S4[4]; \
        _Pragma("unroll") for (int q = 0; q < 4; ++q) S4[q] = (f32x4){0.f, 0.f, 0.f, 0.f}; \
        if (LIVE) { _Pragma("unroll") for (int q = 0; q < 4; ++q) _Pragma("unroll") for (int m = 0; m < 2; ++m) { \
            const v4u kv = *(const LAS v4u*)(Vs + (16 * q + l15) * 144 + 16 * g4 + 64 * m); \
            const long k0 = (long)(((unsigned long long)kv.y << 32) | (unsigned long long)kv.x), k1 = (long)(((unsigned long long)kv.w << 32) | (unsigned long long)kv.z); \
            S4[q] = __builtin_amdgcn_mfma_f32_16x16x32_fp8_fp8(k0, qf[m][0], S4[q], 0, 0, 0); \
            S4[q] = __builtin_amdgcn_mfma_f32_16x16x32_fp8_fp8(k1, qf[m][1], S4[q], 0, 0, 0); } } \
        if (l15 < 4) { _Pragma("unroll") for (int q = 0; q < 4; ++q) _Pragma("unroll") for (int j = 0; j < 4; ++j) { const int kk = (4 * (CH) + q) * 16 + 4 * g4 + j; P[kk * 4 + l15] = kk < n ? S4[q][j] * 0.08838834764831845f : -__builtin_inff(); } } } while (0)
        AT_KLOAD(krA, 0);
        if (nchk > 1) AT_KLOAD(krB, 1);
#pragma unroll 1
        for (int ch = 0; ch < 4; ch += 2) {
            if (ch < nchk) { AT_KSTAGE(krA); if (ch + 2 < nchk) AT_KLOAD(krA, ch + 2); LDS_WAIT(); }
            AT_QK(ch, ch < nchk); LDS_WAIT();
            if (ch + 1 < nchk) { AT_KSTAGE(krB); if (ch + 3 < nchk) AT_KLOAD(krB, ch + 3); LDS_WAIT(); }
            AT_QK(ch + 1, ch + 1 < nchk); LDS_WAIT();
        }
#undef AT_KLOAD
#undef AT_KSTAGE
#undef AT_QK
        LDS_WAIT();
        {
            f32x4 pv[4]; f32x4 mx4 = (f32x4){-__builtin_inff(), -__builtin_inff(), -__builtin_inff(), -__builtin_inff()};
#pragma unroll
            for (int i = 0; i < 4; ++i) { pv[i] = *(const LAS f32x4*)(P + (lane + 64 * i) * 4);
#pragma unroll
                for (int h = 0; h < 4; ++h) mx4[h] = fmaxf(mx4[h], pv[i][h]); }
#pragma unroll
            for (int h = 0; h < 4; ++h) mx4[h] = wave_max(mx4[h]);
            f32x4 sm = (f32x4){0.f, 0.f, 0.f, 0.f};
#pragma unroll
            for (int i = 0; i < 4; ++i)
#pragma unroll
                for (int h = 0; h < 4; ++h) { const float e = __expf(pv[i][h] - mx4[h]); pv[i][h] = e; sm[h] += e; }
#pragma unroll
            for (int h = 0; h < 4; ++h) { sm[h] = wave_sum(sm[h]); sm[h] = 1.0f / sm[h]; }
            LDS_WAIT();
#pragma unroll
            for (int i = 0; i < 4; ++i)
#pragma unroll
                for (int h = 0; h < 4; ++h) P8[h * 256 + lane + 64 * i] = (unsigned char)(f8x4(pv[i][h] * sm[h] * 128.0f, 0.f, 0.f, 0.f) & 0xffu);
        }
        LDS_WAIT();
        f32x4 acc[8];
#pragma unroll
        for (int dt = 0; dt < 8; ++dt) acc[dt] = (f32x4){0.f, 0.f, 0.f, 0.f};
        const int nch = (ntile + 3) >> 2;
        const unsigned vcol = (unsigned)(g * 128 + 16 * (lane & 7));
        v4u vrA[8], vrB[8];
#define AT_VLOAD(VR, CH) do { _Pragma("unroll") for (int i = 0; i < 8; ++i) { const unsigned vo = (unsigned)rows[64 * (CH) + 8 * i + (lane >> 3)] * 512u + vcol; VR[i] = *(const v4u*)(V8 + vo); } } while (0)
#define AT_VSTAGE(VR) do { _Pragma("unroll") for (int i = 0; i < 8; ++i) *(LAS v4u*)(Vs + (8 * i + (lane >> 3)) * 144 + (lane & 7) * 16) = VR[i]; } while (0)
#define AT_PV(CH) do { _Pragma("unroll") for (int ks = 0; ks < 2; ++ks) { long pa = 0l; if (l15 < 4) pa = *(const LAS long*)(P8 + l15 * 256 + 64 * (CH) + 32 * ks + 8 * g4); \
        _Pragma("unroll") for (int dt = 0; dt < 8; ++dt) { const LAS unsigned char* tp = Vs + (32 * ks + 8 * g4 + (l15 >> 1)) * 144 + 16 * dt + 8 * (l15 & 1); \
            const v2i_t tv = __builtin_amdgcn_ds_read_tr8_b64_v2i32((LAS v2i_t*)tp); \
            acc[dt] = __builtin_amdgcn_mfma_f32_16x16x32_fp8_fp8(pa, __builtin_bit_cast(long, tv), acc[dt], 0, 0, 0); } } } while (0)
        AT_VLOAD(vrA, 0);
        if (nch > 1) AT_VLOAD(vrB, 1);
#pragma unroll 1
        for (int ch = 0; ch < nch; ch += 2) {
            AT_VSTAGE(vrA); if (ch + 2 < nch) AT_VLOAD(vrA, ch + 2);
            LDS_WAIT(); AT_PV(ch); LDS_WAIT();
            if (ch + 1 < nch) { AT_VSTAGE(vrB); if (ch + 3 < nch) AT_VLOAD(vrB, ch + 3);
                LDS_WAIT(); AT_PV(ch + 1); LDS_WAIT(); }
        }
#undef AT_VLOAD
#undef AT_VSTAGE
#undef AT_PV
        if (lane < 16) {
#pragma unroll
            for (int dt = 0; dt < 8; ++dt)
#pragma unroll
                for (int j = 0; j < 4; ++j) { const float ov = acc[dt][j] * (1.0f / 128.0f);
                    if (G7_F8) ((unsigned char*)ATT)[(size_t)qrow * D + (4 * g + j) * 128 + 16 * dt + lane] = (unsigned char)f8x4(ov, 0.f, 0.f, 0.f); else ATT[(size_t)qrow * D + (4 * g + j) * 128 + 16 * dt + lane] = (bf16)f2bf(ov); } }
        LDS_WAIT();
    }
}

__device__ __forceinline__ void ph_r1(const Ctx& c) {
    LAS unsigned* lcnt = (LAS unsigned*)(c.lds + 65536);
    if (c.tid < 8) lcnt[c.tid] = 0u;
    bf16* XN = (bf16*)(c.ws + WS_XN); const float* g = c.in[I_MOENORM]; const float* wr = c.in[I_ROUTER];
    LAS f32x4* wl = (LAS f32x4*)c.lds;
    for (int v = c.tid; v < 4096; v += 512) { const int ln = v & 63, hf = (v >> 6) & 1, k = (v >> 7) & 3, j = v >> 9; wl[v] = *(const f32x4*)(wr + (size_t)(4 * (ln + 64 * j) + k) * 8 + 4 * hf); }
    __syncthreads();
    int* TOPI = (int*)(c.ws + WS_TOP); float* TOPG = (float*)(c.ws + WS_TOP) + 65536;
    const int gw = c.bid * 8 + c.wave, NGW = c.G * 8, lane = c.lane;
    f32x4 v[8], nxt[8];
    if (gw < MS) row_load(v, c.out + (size_t)gw * D, lane);
    for (int row = gw; row < MS; row += NGW) {
        if (row + NGW < MS) row_load(nxt, c.out + (size_t)(row + NGW) * D, lane);
        float s = 0.f;
#pragma unroll
        for (int j = 0; j < 8; ++j) s += (v[j].x * v[j].x + v[j].y * v[j].y) + (v[j].z * v[j].z + v[j].w * v[j].w);
        const float rstd = 1.0f / sqrtf(wave_sum(s) * (1.f / D) + EPS);
        float lg[8];
#pragma unroll
        for (int e = 0; e < 8; ++e) lg[e] = 0.f;
        unsigned* o8 = (unsigned*)((unsigned char*)XN + (size_t)row * D) + lane;
#pragma unroll
        for (int j = 0; j < 8; ++j) { const f32x4 gg = ((const f32x4*)g)[lane + 64 * j]; const f32x4 o = v[j] * rstd * gg; o8[64 * j] = f8x4(o.x, o.y, o.z, o.w);
#pragma unroll
            for (int k = 0; k < 4; ++k) { const f32x4 w0 = wl[((j * 4 + k) * 2 + 0) * 64 + lane], w1 = wl[((j * 4 + k) * 2 + 1) * 64 + lane];
                lg[0] += o[k] * w0.x; lg[1] += o[k] * w0.y; lg[2] += o[k] * w0.z; lg[3] += o[k] * w0.w; lg[4] += o[k] * w1.x; lg[5] += o[k] * w1.y; lg[6] += o[k] * w1.z; lg[7] += o[k] * w1.w; } }
#pragma unroll
        for (int e = 0; e < 8; ++e) lg[e] = wave_sum(lg[e]);
        int i0 = 0; float v0 = lg[0];
#pragma unroll
        for (int e = 1; e < 8; ++e) if (lg[e] > v0) { v0 = lg[e]; i0 = e; }
        int i1 = -1; float v1 = -__builtin_inff();
#pragma unroll
        for (int e = 0; e < 8; ++e) if (e != i0 && lg[e] > v1) { v1 = lg[e]; i1 = e; }
        if (lane == 0) { const float e1 = __expf(v1 - v0), g0 = 1.0f / (1.0f + e1);
            TOPI[2 * row] = i0; TOPI[2 * row + 1] = i1; TOPG[2 * row] = g0; TOPG[2 * row + 1] = e1 * g0;
            __hip_atomic_fetch_add(lcnt + i0, 1u, __ATOMIC_RELAXED, __HIP_MEMORY_SCOPE_WORKGROUP); __hip_atomic_fetch_add(lcnt + i1, 1u, __ATOMIC_RELAXED, __HIP_MEMORY_SCOPE_WORKGROUP); }
#pragma unroll
        for (int j = 0; j < 8; ++j) v[j] = nxt[j];
    }
    __syncthreads();
    if (c.tid < 8) ((unsigned*)(c.ws + WS_MOET))[MT_BLKCNT + c.bid * 8 + c.tid] = lcnt[c.tid];
}
__device__ __forceinline__ void ph_r2(const Ctx& c) {
    LAS unsigned* cur = (LAS unsigned*)c.lds;
    unsigned* MT = (unsigned*)(c.ws + WS_MOET);
    LAS unsigned* tot = cur + 8; LAS unsigned* mine = cur + 16;
    if (c.tid < 24) cur[c.tid] = 0u;
    __syncthreads();
    for (int idx = c.tid; idx < c.G * 8; idx += 512) { const unsigned v = ld_agent(MT + MT_BLKCNT + idx); const int bl = idx >> 3, e = idx & 7;
        __hip_atomic_fetch_add(tot + e, v, __ATOMIC_RELAXED, __HIP_MEMORY_SCOPE_WORKGROUP); if (bl < c.bid) __hip_atomic_fetch_add(mine + e, v, __ATOMIC_RELAXED, __HIP_MEMORY_SCOPE_WORKGROUP); }
    __syncthreads();
    if (c.tid < 8) { unsigned start = 0u; for (int e = 0; e < c.tid; ++e) start += ((tot[e] + 255u) >> 8) << 8;
        cur[c.tid] = start + mine[c.tid];
        if (c.bid == 0) { const unsigned nt_e = (tot[c.tid] + 255u) >> 8, t0 = start >> 8; for (unsigned k = 0; k < nt_e; ++k) MT[MT_TILEEXP + t0 + k] = (unsigned)c.tid;
            if (c.tid == 7) MT[MT_NTILES] = t0 + nt_e; } }
    __syncthreads();
    const unsigned char* XN = c.ws + WS_XN; unsigned char* XG = c.ws + WS_XG;
    const int* TOPI = (const int*)(c.ws + WS_TOP); int* POS = (int*)(c.ws + WS_TOP) + 131072;
    const int gw = c.bid * 8 + c.wave, NGW = c.G * 8, lane = c.lane;
    v4u dv[2], nv[2]; int e0 = 0, e1 = 0, ne0 = 0, ne1 = 0;
    if (gw < MS) { e0 = TOPI[2 * gw]; e1 = TOPI[2 * gw + 1]; const v4u* src = (const v4u*)(XN + (size_t)gw * D);
#pragma unroll
        for (int j = 0; j < 2; ++j) dv[j] = src[lane + 64 * j]; }
    for (int row = gw; row < MS; row += NGW) {
        const int nrow = row + NGW;
        if (nrow < MS) { ne0 = TOPI[2 * nrow]; ne1 = TOPI[2 * nrow + 1]; const v4u* src = (const v4u*)(XN + (size_t)nrow * D);
#pragma unroll
            for (int j = 0; j < 2; ++j) nv[j] = src[lane + 64 * j]; }
        int p0 = 0, p1 = 0;
        if (lane == 0) { p0 = (int)__hip_atomic_fetch_add(cur + e0, 1u, __ATOMIC_RELAXED, __HIP_MEMORY_SCOPE_WORKGROUP); p1 = (int)__hip_atomic_fetch_add(cur + e1, 1u, __ATOMIC_RELAXED, __HIP_MEMORY_SCOPE_WORKGROUP);
            POS[2 * row] = p0; POS[2 * row + 1] = p1; }
        p0 = __shfl(p0, 0); p1 = __shfl(p1, 0);
        v4u* d0 = (v4u*)(XG + (size_t)p0 * D); v4u* d1 = (v4u*)(XG + (size_t)p1 * D);
#pragma unroll
        for (int j = 0; j < 2; ++j) { d0[lane + 64 * j] = dv[j]; d1[lane + 64 * j] = dv[j]; dv[j] = nv[j]; }
        e0 = ne0; e1 = ne1;
    }
}
struct FinRow { f32x4 h[8]; v2u y0[8], y1[8]; float g0, g1; };
__device__ __forceinline__ void fin_load(FinRow& r, const Ctx& c, int row, int lane) {
    const bf16* Y = (const bf16*)(c.ws + WS_Y); const float* TOPG = (const float*)(c.ws + WS_TOP) + 65536; const int* POS = (const int*)(c.ws + WS_TOP) + 131072;
    r.g0 = TOPG[2 * row]; r.g1 = TOPG[2 * row + 1];
    const v2u* y0 = (const v2u*)(Y + (size_t)POS[2 * row] * D) + lane; const v2u* y1 = (const v2u*)(Y + (size_t)POS[2 * row + 1] * D) + lane;
    const f32x4* xr = (const f32x4*)(c.out + (size_t)row * D) + lane;
#pragma unroll
    for (int j = 0; j < 8; ++j) { r.h[j] = xr[64 * j]; r.y0[j] = y0[64 * j]; r.y1[j] = y1[64 * j]; }
}
__device__ __forceinline__ void ph_final(const Ctx& c) {
    const float* g = c.in[I_FINALNORM];
    const int gw = c.bid * 8 + c.wave, NGW = c.G * 8, lane = c.lane;
    FinRow cur, nxt;
    if (gw < MS) fin_load(cur, c, gw, lane);
    for (int row = gw; row < MS; row += NGW) {
        if (row + NGW < MS) fin_load(nxt, c, row + NGW, lane);
        f32x4* xr = (f32x4*)(c.out + (size_t)row * D) + lane; f32x4 v[8]; float s = 0.f;
#pragma unroll
        for (int j = 0; j < 8; ++j) { const v2u a = cur.y0[j], bq = cur.y1[j];
            f32x4 ya, yb;
            ya.x = __builtin_bit_cast(float, a.x << 16); ya.y = __builtin_bit_cast(float, a.x & 0xffff0000u); ya.z = __builtin_bit_cast(float, a.y << 16); ya.w = __builtin_bit_cast(float, a.y & 0xffff0000u);
            yb.x = __builtin_bit_cast(float, bq.x << 16); yb.y = __builtin_bit_cast(float, bq.x & 0xffff0000u); yb.z = __builtin_bit_cast(float, bq.y << 16); yb.w = __builtin_bit_cast(float, bq.y & 0xffff0000u);
            v[j] = cur.h[j] + cur.g0 * ya + cur.g1 * yb; s += (v[j].x * v[j].x + v[j].y * v[j].y) + (v[j].z * v[j].z + v[j].w * v[j].w); }
        const float rstd = 1.0f / sqrtf(wave_sum(s) * (1.f / D) + EPS);
#pragma unroll
        for (int j = 0; j < 8; ++j) { const f32x4 gg = ((const f32x4*)g)[lane + 64 * j]; xr[64 * j] = v[j] * rstd * gg; }
        cur = nxt;
    }
}

template <int K>
__device__ __forceinline__ void meta_resid(const Ctx& c, const bf16* A, const bf16* Bt) {
    float* hm = (float*)(c.ws + WS_HMPAD); LAS f32x4* part = (LAS f32x4*)c.lds;
    const int lane = c.lane, g4 = lane >> 4, l15 = lane & 15;
    constexpr int KS = K / 32 / 8;
    for (int nt = c.bid; nt < 128; nt += c.G) {
        const bf16* ap = A + (size_t)(MS + l15) * K + c.wave * KS * 32 + 8 * g4; const bf16* bp = Bt + (size_t)(nt * 16 + l15) * K + c.wave * KS * 32 + 8 * g4;
        f32x4 acc = (f32x4){0.f, 0.f, 0.f, 0.f};
        for (int k0 = 0; k0 < KS; k0 += 8) { bf16x8 af[8], bfr[8];
#pragma unroll
            for (int i = 0; i < 8; ++i) { const int kk = k0 + i < KS ? k0 + i : KS - 1; af[i] = *(const bf16x8*)(ap + kk * 32); bfr[i] = *(const bf16x8*)(bp + kk * 32); }
#pragma unroll
            for (int i = 0; i < 8; ++i) if (k0 + i < KS) acc = __builtin_amdgcn_mfma_f32_16x16x32_bf16(af[i], bfr[i], acc, 0, 0, 0); }
        part[c.wave * 64 + lane] = acc;
        __syncthreads();
        if (c.wave == 0) { f32x4 t = part[lane];
#pragma unroll
            for (int w = 1; w < 8; ++w) t += part[w * 64 + lane];
#pragma unroll
            for (int j = 0; j < 4; ++j) { float* p = hm + (size_t)(4 * g4 + j) * D + nt * 16 + l15; *p = *p + t[j]; } }
        __syncthreads();
    }
}
template <int NJ>
__device__ __forceinline__ void meta_swiglu(const Ctx& c, const bf16* A, const bf16* Wgu, bf16* O, int ldo) {
    LAS f32x4* part = (LAS f32x4*)c.lds;
    const int lane = c.lane, g4 = lane >> 4, l15 = lane & 15;
    for (int it = c.bid; it < NJ * 8; it += c.G) {
        const int jg = it >> 3, sub = it & 7;
        const bf16* ap = A + (size_t)(MS + l15) * D + c.wave * 256 + 8 * g4; const bf16* gp = Wgu + (size_t)(256 * jg + 16 * sub + l15) * D + c.wave * 256 + 8 * g4; const bf16* up = gp + (size_t)128 * D;
        f32x4 ag = (f32x4){0.f, 0.f, 0.f, 0.f}, au = ag;
        bf16x8 af[8], gf[8], uf[8];
#pragma unroll
        for (int i = 0; i < 8; ++i) { af[i] = *(const bf16x8*)(ap + i * 32); gf[i] = *(const bf16x8*)(gp + i * 32); uf[i] = *(const bf16x8*)(up + i * 32); }
#pragma unroll
        for (int i = 0; i < 8; ++i) { ag = __builtin_amdgcn_mfma_f32_16x16x32_bf16(af[i], gf[i], ag, 0, 0, 0); au = __builtin_amdgcn_mfma_f32_16x16x32_bf16(af[i], uf[i], au, 0, 0, 0); }
        part[c.wave * 64 + lane] = ag; part[512 + c.wave * 64 + lane] = au;
        __syncthreads();
        if (c.wave == 0) { f32x4 tg = part[lane], tu = part[512 + lane];
#pragma unroll
            for (int w = 1; w < 8; ++w) { tg += part[w * 64 + lane]; tu += part[512 + w * 64 + lane]; }
#pragma unroll
            for (int j = 0; j < 4; ++j) O[(size_t)(MS + 4 * g4 + j) * ldo + 128 * jg + 16 * sub + l15] = (bf16)f2bf(siluf_(tg[j]) * tu[j]); }
        __syncthreads();
    }
}

template <int K>
__device__ __forceinline__ void meta_resid_f8(const Ctx& c, const unsigned char* A, const unsigned char* Bt, float sc) {
    float* hm = (float*)(c.ws + WS_HMPAD); LAS f32x4* part = (LAS f32x4*)c.lds;
    const int lane = c.lane, g4 = lane >> 4, l15 = lane & 15;
    constexpr int KS = K / 32 / 8;
    for (int nt = c.bid; nt < 128; nt += c.G) {
        const unsigned char* ap = A + (size_t)(MS + l15) * K + c.wave * KS * 32 + 8 * g4; const unsigned char* bp = Bt + (size_t)(nt * 16 + l15) * K + c.wave * KS * 32 + 8 * g4;
        f32x4 acc = (f32x4){0.f, 0.f, 0.f, 0.f};
        for (int k0 = 0; k0 < KS; k0 += 8) { long af[8], bfr[8];
#pragma unroll
            for (int i = 0; i < 8; ++i) { const int kk = k0 + i < KS ? k0 + i : KS - 1; af[i] = *(const long*)(ap + kk * 32); bfr[i] = *(const long*)(bp + kk * 32); }
#pragma unroll
            for (int i = 0; i < 8; ++i) if (k0 + i < KS) acc = __builtin_amdgcn_mfma_f32_16x16x32_fp8_fp8(af[i], bfr[i], acc, 0, 0, 0); }
        part[c.wave * 64 + lane] = acc;
        __syncthreads();
        if (c.wave == 0) { f32x4 t = part[lane];
#pragma unroll
            for (int w = 1; w < 8; ++w) t += part[w * 64 + lane];
#pragma unroll
            for (int j = 0; j < 4; ++j) { float* p = hm + (size_t)(4 * g4 + j) * D + nt * 16 + l15; *p = *p + t[j] * sc; } }
        __syncthreads();
    }
}
template <int NJ>
__device__ __forceinline__ void meta_swiglu_f8(const Ctx& c, const unsigned char* A, const unsigned char* Wgu, unsigned char* O, int ldo, float sc) {
    LAS f32x4* part = (LAS f32x4*)c.lds;
    const int lane = c.lane, g4 = lane >> 4, l15 = lane & 15;
    for (int it = c.bid; it < NJ * 8; it += c.G) {
        const int jg = it >> 3, sub = it & 7;
        const unsigned char* ap = A + (size_t)(MS + l15) * D + c.wave * 256 + 8 * g4; const unsigned char* gp = Wgu + (size_t)(256 * jg + 16 * sub + l15) * D + c.wave * 256 + 8 * g4; const unsigned char* up = gp + (size_t)128 * D;
        f32x4 ag = (f32x4){0.f, 0.f, 0.f, 0.f}, au = ag;
        long af[8], gf[8], uf[8];
#pragma unroll
        for (int i = 0; i < 8; ++i) { af[i] = *(const long*)(ap + i * 32); gf[i] = *(const long*)(gp + i * 32); uf[i] = *(const long*)(up + i * 32); }
#pragma unroll
        for (int i = 0; i < 8; ++i) { ag = __builtin_amdgcn_mfma_f32_16x16x32_fp8_fp8(af[i], gf[i], ag, 0, 0, 0); au = __builtin_amdgcn_mfma_f32_16x16x32_fp8_fp8(af[i], uf[i], au, 0, 0, 0); }
        part[c.wave * 64 + lane] = ag; part[512 + c.wave * 64 + lane] = au;
        __syncthreads();
        if (c.wave == 0) { f32x4 tg = part[lane], tu = part[512 + lane];
#pragma unroll
            for (int w = 1; w < 8; ++w) { tg += part[w * 64 + lane]; tu += part[512 + w * 64 + lane]; }
#pragma unroll
            for (int j = 0; j < 4; ++j) O[(size_t)(MS + 4 * g4 + j) * ldo + 128 * jg + 16 * sub + l15] = (unsigned char)(f8x4(siluf_(tg[j] * sc) * (tu[j] * sc), 0.f, 0.f, 0.f) & 0xffu); }
        __syncthreads();
    }
}

template <int NJ>
__device__ __forceinline__ void meta_swiglu_i8(const Ctx& c, const unsigned char* A, const float* xs, const unsigned char* Wgu, const float* wsc, unsigned char* O, int ldo) {
    LAS v4i_t* part = (LAS v4i_t*)c.lds;
    const int lane = c.lane, g4 = lane >> 4, l15 = lane & 15;
    for (int it = c.bid; it < NJ * 8; it += c.G) {
        const int jg = it >> 3, sub = it & 7;
        const unsigned char* ap = A + (size_t)(MS + l15) * D + c.wave * 256 + 16 * g4; const unsigned char* gp = Wgu + (size_t)(256 * jg + 16 * sub + l15) * D + c.wave * 256 + 16 * g4; const unsigned char* up = gp + (size_t)128 * D;
        v4i_t ag = (v4i_t){0, 0, 0, 0}, au = ag;
        v4i_t af[4], gf[4], uf[4];
#pragma unroll
        for (int i = 0; i < 4; ++i) { af[i] = *(const v4i_t*)(ap + i * 64); gf[i] = *(const v4i_t*)(gp + i * 64); uf[i] = *(const v4i_t*)(up + i * 64); }
#pragma unroll
        for (int i = 0; i < 4; ++i) { ag = __builtin_amdgcn_mfma_i32_16x16x64_i8(af[i], gf[i], ag, 0, 0, 0); au = __builtin_amdgcn_mfma_i32_16x16x64_i8(af[i], uf[i], au, 0, 0, 0); }
        part[c.wave * 64 + lane] = ag; part[512 + c.wave * 64 + lane] = au;
        __syncthreads();
        if (c.wave == 0) { v4i_t tg = part[lane], tu = part[512 + lane];
#pragma unroll
            for (int w = 1; w < 8; ++w) { tg += part[w * 64 + lane]; tu += part[512 + w * 64 + lane]; }
            const float sg = wsc[256 * jg + 16 * sub + l15], su = wsc[256 * jg + 128 + 16 * sub + l15];
#pragma unroll
            for (int j = 0; j < 4; ++j) { const float rs = xs[MS + 4 * g4 + j];
                O[(size_t)(MS + 4 * g4 + j) * ldo + 128 * jg + 16 * sub + l15] = (unsigned char)(f8x4(siluf_((float)tg[j] * rs * sg) * ((float)tu[j] * rs * su), 0.f, 0.f, 0.f) & 0xffu); } }
        __syncthreads();
    }
}

enum { PH_PRE = 0, PH_PRE2, PH_G1, PH_CONV, PH_G2, PH_SCANA, PH_SCANC, PH_G3, PH_NORM1, PH_G4, PH_G5, PH_NORM2, PH_G6, PH_ROPE, PH_INDEX, PH_ATTN, PH_G7,
       PH_R1, PH_R2, PH_M0A, PH_M0B, PH_M1B, PH_M2B, PH_FINAL, NPH };

__global__ void __launch_bounds__(512, 2) mega(Args args) {
    extern __shared__ __attribute__((aligned(16))) unsigned char lds_raw[];
    Ctx c; c.out = args.out; c.ws = args.ws; c.lds = (LAS unsigned char*)lds_raw;
    c.tid = threadIdx.x; c.lane = c.tid & 63; c.wave = __builtin_amdgcn_readfirstlane(c.tid >> 6); c.G = gridDim.x; c.bid = blockIdx.x;
    volatile LAS unsigned* misc = (volatile LAS unsigned*)(c.lds + LDS_MISC);
    if (c.tid < 64) misc[c.tid] = 0u;
    __syncthreads();
    const int lo = args.ph_lo, hi = args.ph_hi;
    XcdBarrier bar; bar.bar = (unsigned*)(c.ws + WS_CTL) + CW_BAR; bar.x = 0; bar.st = misc + 8;
    if (hi - lo > 1) bar = xcd_barrier_post((unsigned*)(c.ws + WS_CTL) + CW_BAR, misc + 8);
#ifndef PH_ENABLE
#define PH_ENABLE 0xFFFFFFFFull
#endif
#define IN(k) ((((PH_ENABLE) >> (k)) & 1ull) && lo <= (k) && (k) < hi)
#define SEAM(k) do { if (IN(k) && IN((k) + 1)) xcd_barrier(bar); else __syncthreads(); } while (0)
    unsigned char* ws = c.ws;
    bf16* XN = (bf16*)(ws + WS_XN); float* HMPAD = (float*)(ws + WS_HMPAD);

#ifndef DUP_MASK
#define DUP_MASK 0ull
#endif
#ifndef PROBE_MULT
#define PROBE_MULT 0
#endif
#define PROBE_ON(k) (PROBE_MULT > 0 && (((DUP_MASK) >> (k)) & 1ull) && c.bid == 0 && c.tid == 0)
#define PHASE(k, ...) if (IN(k)) { if (PROBE_ON(k)) { const unsigned long long t_ = __builtin_amdgcn_s_memrealtime(); misc[16] = (unsigned)t_; misc[17] = (unsigned)(t_ >> 32); } \
    __VA_ARGS__ SEAM(k); \
    if (PROBE_ON(k)) { const unsigned long long t0_ = (unsigned long long)misc[16] | ((unsigned long long)misc[17] << 32), d_ = __builtin_amdgcn_s_memrealtime() - t0_; \
        const unsigned long long a_ = ((unsigned long long)misc[18] | ((unsigned long long)misc[19] << 32)) + d_; misc[18] = (unsigned)a_; misc[19] = (unsigned)(a_ >> 32); } }
    PHASE(PH_PRE, ph_pre(c);)
    PHASE(PH_PRE2, ph_pre2(c);)
    PHASE(PH_G1,
        { gm::DenseSched S{129, NABP / 256, c.G, c.bid, (const char*)(ws + WS_XN), (const char*)(ws + WS_WINAB), D, D, 0};
        gm::EpiBf16I8 E{(bf16*)(ws + WS_Z0), NABP, (const float*)(ws + WS_XS), (const float*)(ws + WS_WSC) + WMX_AB};
        gm::gemm_phase<gm::EpiBf16I8, gm::DenseSched, 2>(c.lds, S, E, D / 128, D, D); })
    PHASE(PH_CONV, ph_conv(c); __syncthreads(); ph_gla0(c);)
    PHASE(PH_G2,
        { gm::DenseSched S{129, 8, c.G, c.bid, (const char*)(ws + WS_XC), (const char*)(ws + WS_WRI), 1024 * 2, 256 * 2, 1};
        gm::EpiBf16 E{(bf16*)(ws + WS_RI), D, 0};
        gm::gemm_phase(c.lds, S, E, 4, 1024 * 2, 256 * 2); }
        __syncthreads(); ph_gla1(c);)
#define SUBPROBE(id, ...) { if (PROBE_ON(32 + (id))) { const unsigned long long t_ = __builtin_amdgcn_s_memrealtime(); misc[16] = (unsigned)t_; misc[17] = (unsigned)(t_ >> 32); } \
    __VA_ARGS__ \
    if (PROBE_ON(32 + (id))) { const unsigned long long t0_ = (unsigned long long)misc[16] | ((unsigned long long)misc[17] << 32), d_ = __builtin_amdgcn_s_memrealtime() - t0_; \
        const unsigned long long a_ = ((unsigned long long)misc[18] | ((unsigned long long)misc[19] << 32)) + d_; misc[18] = (unsigned)a_; misc[19] = (unsigned)(a_ >> 32); } }
    PHASE(PH_SCANA, SUBPROBE(0, ph_scan_a(c);) SUBPROBE(1, ph_gla2(c);))
    PHASE(PH_SCANC, SUBPROBE(2, ph_scan_c(c);) SUBPROBE(3, __syncthreads(); ph_gla3(c);))
    PHASE(PH_G3,
        { if (G3_F8) { meta_resid_f8<D>(c, ws + WS_MIX, ws + WS_WOUTAB, 1.0f / MOE_WS_GU);
            gm::DenseSched S{128, 8, c.G, c.bid, (const char*)(ws + WS_MIX), (const char*)(ws + WS_WOUTAB), D, D, 0};
            gm::EpiResid E{c.in[I_X], c.out, HMPAD, 1.0f / MOE_WS_GU};
            gm::gemm_phase<gm::EpiResid, gm::DenseSched, 1>(c.lds, S, E, D / 128, D, D); }
        else { meta_resid<D>(c, (const bf16*)(ws + WS_MIX), (const bf16*)(ws + WS_WOUTAB));
        gm::DenseSched S{128, 8, c.G, c.bid, (const char*)(ws + WS_MIX), (const char*)(ws + WS_WOUTAB), D * 2, D * 2, 0};
        gm::EpiResid E{c.in[I_X], c.out, HMPAD};
        gm::gemm_phase(c.lds, S, E, D / 64, D * 2, D * 2); } })
    PHASE(PH_NORM1, norm_phase_i8(c, c.out, c.in[I_FFNNORM]);)
    PHASE(PH_G4,
        { meta_swiglu_i8<44>(c, ws + WS_XN, (const float*)(ws + WS_XS), ws + WS_WGU, (const float*)(ws + WS_WSC) + WMX_GU, ws + WS_ACT, DFF);
        gm::DenseSched S{128, 44, c.G, c.bid, (const char*)(ws + WS_XN), (const char*)(ws + WS_WGU), D, D, 0};
        gm::EpiSwigluI8 E{ws + WS_ACT, DFF, (const float*)(ws + WS_XS), (const float*)(ws + WS_WSC) + WMX_GU};
        gm::gemm_phase<gm::EpiSwigluI8, gm::DenseSched, 2>(c.lds, S, E, D / 128, D, D); })
    PHASE(PH_G5,
        { meta_resid_f8<DFF>(c, ws + WS_ACT, ws + WS_WDOWN, 1.0f / MOE_WS_D);
        gm::DenseSched S{128, 8, c.G, c.bid, (const char*)(ws + WS_ACT), (const char*)(ws + WS_WDOWN), DFF, DFF, 0};
        gm::EpiResid E{c.out, c.out, HMPAD, 1.0f / MOE_WS_D};
        gm::gemm_phase<gm::EpiResid, gm::DenseSched, true>(c.lds, S, E, DFF / 128, DFF, DFF); })
    PHASE(PH_NORM2, norm_phase_i8(c, c.out, c.in[I_CNORM]);)
    PHASE(PH_G6,
        { gm::DenseSched S{129, NCP / 256, c.G, c.bid, (const char*)(ws + WS_XN), (const char*)(ws + WS_WINC), D, D, 0};
        gm::EpiBf16I8 E{(bf16*)(ws + WS_Z1), NCP, (const float*)(ws + WS_XS), (const float*)(ws + WS_WSC) + WMX_C};
        gm::gemm_phase<gm::EpiBf16I8, gm::DenseSched, 2>(c.lds, S, E, D / 128, D, D); })
    PHASE(PH_ROPE, ph_rope(c);)
    PHASE(PH_INDEX, if (c.wave < 4) { ph_moecvt(c); ph_index(c); } else { ph_index(c); ph_moecvt(c); })
    PHASE(PH_ATTN, ph_attn(c);)
    PHASE(PH_G7,
        { if (G7_F8) { gm::DenseSched S{128, 8, c.G, c.bid, (const char*)(ws + WS_ATT), (const char*)(ws + WS_WOUTC), D, D, 0};
            gm::EpiResid E{c.out, c.out, HMPAD, 1.0f / MOE_WS_GU};
            gm::gemm_phase<gm::EpiResid, gm::DenseSched, 1>(c.lds, S, E, D / 128, D, D); }
        else { gm::DenseSched S{128, 8, c.G, c.bid, (const char*)(ws + WS_ATT), (const char*)(ws + WS_WOUTC), D * 2, D * 2, 0};
        gm::EpiResid E{c.out, c.out, HMPAD};
        gm::gemm_phase(c.lds, S, E, D / 64, D * 2, D * 2); } })
    PHASE(PH_R1, ph_r1(c);)
    PHASE(PH_R2, ph_r2(c);)
    constexpr size_t ACT2_BUF = (size_t)MOE_PASS_TILES * 256 * DEXP;
#define MOE_A(p) { const int ntl = (int)ld_agent((const unsigned*)(ws + WS_MOET) + MT_NTILES); int nM = ntl - (p) * MOE_PASS_TILES; nM = nM < 0 ? 0 : (nM > MOE_PASS_TILES ? MOE_PASS_TILES : nM); \
        gm::MoeSched S{nM, 56, c.G, c.bid, (const char*)(ws + WS_XG), D, (p) * MOE_PASS_TILES, (const char*)(ws + WS_WMGU), D, (size_t)14336 * D, (const unsigned*)(ws + WS_MOET) + MT_TILEEXP, (p) * MOE_PASS_TILES}; \
        gm::EpiSwigluF8 E{ws + WS_ACT2 + ((p) & 1) * ACT2_BUF, DEXP, 1.0f / MOE_WS_GU}; \
        gm::gemm_phase<gm::EpiSwigluF8, gm::MoeSched, true>(c.lds, S, E, D / 128, D, D); }
#define MOE_B(p) { const int ntl = (int)ld_agent((const unsigned*)(ws + WS_MOET) + MT_NTILES); int nM = ntl - (p) * MOE_PASS_TILES; nM = nM < 0 ? 0 : (nM > MOE_PASS_TILES ? MOE_PASS_TILES : nM); \
        gm::MoeSched S{nM, 8, c.G, c.bid, (const char*)(ws + WS_ACT2 + ((p) & 1) * ACT2_BUF), DEXP, 0, (const char*)(ws + WS_WMD), DEXP, (size_t)D * DEXP, (const unsigned*)(ws + WS_MOET) + MT_TILEEXP, (p) * MOE_PASS_TILES}; \
        gm::EpiBf16 E{(bf16*)(ws + WS_Y), D, (p) * MOE_PASS_TILES * 256, 1.0f / MOE_WS_D}; \
        gm::gemm_phase<gm::EpiBf16, gm::MoeSched, true>(c.lds, S, E, DEXP / 128, DEXP, DEXP); }
    PHASE(PH_M0A, MOE_A(0))
    PHASE(PH_M0B, MOE_B(0) __syncthreads(); MOE_A(1))
    PHASE(PH_M1B, MOE_B(1) __syncthreads(); MOE_A(2))
    PHASE(PH_M2B, MOE_B(2))
    PHASE(PH_FINAL, ph_final(c);)
    if (PROBE_MULT > 0 && c.bid == 0 && c.tid == 0) { const unsigned long long a_ = ((unsigned long long)misc[18] | ((unsigned long long)misc[19] << 32)) * (unsigned long long)(PROBE_MULT);
        const unsigned long long t0_ = __builtin_amdgcn_s_memrealtime(); while (__builtin_amdgcn_s_memrealtime() - t0_ < a_) __builtin_amdgcn_s_sleep(32); }
#undef IN
#undef SEAM
}

extern "C" void kernel_launch(void* const* d_in, const int* in_sizes, int n_in, void* d_out, int out_size, void* d_ws, size_t ws_size, hipStream_t stream) {
    static int grid = 0;
    if (grid == 0) {
        if (n_in != 28 || ws_size < WS_END) { fprintf(stderr, "kernel_launch: need 28 inputs and >= %zu bytes of workspace; got %d, %zu\n", (size_t)WS_END, n_in, ws_size); }
        int dev = 0, cus = 0, per_cu = 0;
        hipGetDevice(&dev); hipDeviceGetAttribute(&cus, hipDeviceAttributeMultiprocessorCount, dev);
        if (hipFuncSetAttribute((const void*)mega, hipFuncAttributeMaxDynamicSharedMemorySize, LDS_BYTES) != hipSuccess) fprintf(stderr, "kernel_launch: hipFuncSetAttribute failed\n");
        if (hipOccupancyMaxActiveBlocksPerMultiprocessor(&per_cu, (const void*)mega, 512, LDS_BYTES) != hipSuccess || per_cu < 1) fprintf(stderr, "kernel_launch: occupancy query says %d\n", per_cu);
        (void)hipGetLastError();
        grid = cus > 0 ? cus : 256;
        if (grid % 8) grid -= grid % 8;
    }
    hipMemsetAsync((char*)d_ws + WS_CTL, 0, 1 * MiB, stream);
    Args a{};
    for (int i = 0; i < 28; ++i) a.in[i] = (const float*)d_in[i];
    a.out = (float*)d_out; a.ws = (unsigned char*)d_ws; a.dup = (DUP_MASK);
#if N_LAUNCH_MODE == 1
    a.ph_lo = 0; a.ph_hi = NPH;
    hipLaunchKernelGGL(mega, dim3(grid), dim3(512), LDS_BYTES, stream, a);
#else
    for (int p = 0; p < NPH; ++p) { a.ph_lo = p; a.ph_hi = p + 1; hipLaunchKernelGGL(mega, dim3(grid), dim3(512), LDS_BYTES, stream, a); }
#endif
    const hipError_t le = hipPeekAtLastError();
    if (le != hipSuccess) fprintf(stderr, "kernel_launch: launch failed: %s\n", hipGetErrorName(le));
}
```

```cpp
#include <hip/hip_runtime.h>
#include <cstdio>
#include <cstdint>

#define GAS __attribute__((address_space(1)))
#define LAS __attribute__((address_space(3)))
typedef unsigned short bf16;
typedef unsigned v4u __attribute__((ext_vector_type(4)));
typedef unsigned v2u __attribute__((ext_vector_type(2)));
typedef float f32x4 __attribute__((ext_vector_type(4)));
typedef float f32x2 __attribute__((ext_vector_type(2)));
typedef short bf16x8 __attribute__((ext_vector_type(8)));
typedef _Float16 h2_t __attribute__((ext_vector_type(2)));
typedef short s16x4_t __attribute__((ext_vector_type(4)));
typedef int v2i_t __attribute__((ext_vector_type(2)));

#ifndef G3_F8
#define G3_F8 1
#endif
#ifndef G7_F8
#define G7_F8 1
#endif
#ifndef N_LAUNCH_MODE
#define N_LAUNCH_MODE 1
#endif

constexpr int D = 2048, SEQ = 16384, NMETA = 16, TT = 16400;
constexpr int MS = 32768;
constexpr int MR = 32784;
constexpr int MP = 33024;
constexpr int NAB = 5136, NABP = 5376, NC = 3656, NCP = 3840, DFF = 5632, DEXP = 7168;
constexpr int GLA_UNITS = 4 + 2 * 256 * 4;
constexpr int MOE_PASS_TILES = 96;
constexpr float EPS = 1e-6f;
constexpr float MOE_WS_GU = 32.0f, MOE_WS_D = 64.0f;
__device__ __forceinline__ size_t kip_off(int t, int ch) { return ((size_t)(t >> 4) * 128 + (ch >> 2) * 64 + (ch & 3) * 16 + (t & 15)) * 8; }
constexpr int KIP_STRIDE = TT + 272;

constexpr size_t MiB = 1u << 20;
constexpr size_t WS_CTL = 0;
constexpr size_t WS_HMPAD = 1 * MiB;
constexpr size_t WS_ROPE = 3 * MiB;
constexpr size_t WS_LSUM = 6 * MiB + 512 * 1024;
constexpr size_t WS_DEC = 8 * MiB;
constexpr size_t WS_WIS = 10 * MiB;
constexpr size_t WS_MOET = 12 * MiB;
constexpr size_t WS_TOP = 13 * MiB;
constexpr size_t WS_XS = 13 * MiB + 800 * 1024;
constexpr size_t WS_WSC = 12 * MiB + 64 * 1024;
constexpr size_t WS_WINC = 14 * MiB;
constexpr size_t WS_WOUTC = 29 * MiB;
constexpr size_t WS_XN = 37 * MiB;
constexpr size_t WS_WM = 166 * MiB;
constexpr size_t WS_WMGU = WS_WM, WS_WMD = WS_WM + 224 * MiB;
constexpr size_t WS_R = 838 * MiB;
constexpr size_t WS_HB = 700 * MiB;
constexpr size_t WS_Z0 = 166 * MiB;
constexpr size_t WS_XC = 505 * MiB;
constexpr size_t WS_RI = 570 * MiB;
constexpr size_t WS_WINAB = WS_R + 0 * MiB;
constexpr size_t WS_WRI = WS_R + 21 * MiB;
constexpr size_t WS_WOUTAB = WS_R + 22 * MiB;
constexpr size_t WS_WGU = WS_R + 30 * MiB;
constexpr size_t WS_WDOWN = WS_R + 74 * MiB;
constexpr size_t WS_MIX = WS_R + 96 * MiB;
constexpr size_t WS_DST = WS_R + 225 * MiB;
constexpr size_t WS_ST = WS_R + 482 * MiB;
constexpr size_t WS_ACT = WS_R + 225 * MiB;
constexpr size_t WS_QDG = WS_R + 610 * MiB;
constexpr size_t WS_KDG = WS_R + 643 * MiB;
constexpr size_t WS_KDTG = WS_R + 676 * MiB;
constexpr size_t WS_VTG = WS_R + 709 * MiB;
constexpr size_t WS_Z1 = WS_R + 0 * MiB;
constexpr size_t WS_KIP = WS_R + 242 * MiB;
constexpr size_t WS_SEL = WS_R + 247 * MiB;
constexpr size_t WS_SELCNT = WS_R + 262 * MiB;
constexpr size_t WS_ATT = WS_R + 263 * MiB;
constexpr size_t WS_K8 = WS_R + 392 * MiB;
constexpr size_t WS_V8 = WS_R + 409 * MiB;
constexpr size_t WS_XG = WS_R + 0 * MiB;
constexpr size_t WS_ACT2 = WS_R + 264 * MiB;
constexpr size_t WS_Y = WS_R + 628 * MiB;
constexpr size_t WS_END = WS_R + 892 * MiB;
constexpr int MT_BLKCNT = 0;
constexpr int MT_TILEEXP = 8192;
constexpr int MT_NTILES = 8192 + 512;
constexpr int CW_BAR = 4096;
constexpr int CW_WMAX = 65536;
constexpr int WMX_AB = 0, WMX_GU = 5376, WMX_C = 16640;

constexpr int LDS_BYTES = 159744;
constexpr int LDS_MISC = 158720;

__device__ __forceinline__ float bf2f(bf16 v) { return __builtin_bit_cast(float, (unsigned)v << 16); }
typedef __bf16 bf2_t __attribute__((ext_vector_type(2)));
__device__ __forceinline__ unsigned pk2(float lo, float hi) { const f32x2 v = {lo, hi}; return __builtin_bit_cast(unsigned, __builtin_convertvector(v, bf2_t)); }
__device__ __forceinline__ unsigned f2bf(float f) { return pk2(f, 0.f) & 0xffffu; }
__device__ __forceinline__ unsigned f8x4(float a, float b, float c, float d) {
    unsigned w = 0u; w = __builtin_amdgcn_cvt_pk_fp8_f32(a, b, w, false); w = __builtin_amdgcn_cvt_pk_fp8_f32(c, d, w, true); return w; }
typedef int v8i_t __attribute__((ext_vector_type(8)));
typedef int v4i_t __attribute__((ext_vector_type(4)));
template <int CTRL> __device__ __forceinline__ float dpp_(float v) { return __builtin_bit_cast(float, __builtin_amdgcn_update_dpp(0, __builtin_bit_cast(int, v), CTRL, 0xf, 0xf, true)); }
__device__ __forceinline__ float row_sum16(float v) { v += dpp_<0xB1>(v); v += dpp_<0x4E>(v); v += dpp_<0x124>(v); v += dpp_<0x128>(v); return v; }
__device__ __forceinline__ float row_max16(float v) { v = fmaxf(v, dpp_<0xB1>(v)); v = fmaxf(v, dpp_<0x4E>(v)); v = fmaxf(v, dpp_<0x124>(v)); v = fmaxf(v, dpp_<0x128>(v)); return v; }
__device__ __forceinline__ float wave_sum(float v) { v = row_sum16(v); v += __shfl_xor(v, 16); v += __shfl_xor(v, 32); return v; }
__device__ __forceinline__ float wave_max(float v) { v = row_max16(v); v = fmaxf(v, __shfl_xor(v, 16)); v = fmaxf(v, __shfl_xor(v, 32)); return v; }
#define LDS_WAIT() asm volatile("s_waitcnt lgkmcnt(0)" ::: "memory")
#define VM_WAIT() asm volatile("s_waitcnt vmcnt(0)" ::: "memory")
__device__ __forceinline__ float rcp_(float x) { return __builtin_amdgcn_rcpf(x); }
__device__ __forceinline__ float sigmoidf_(float x) { return rcp_(1.0f + __expf(-x)); }
__device__ __forceinline__ float siluf_(float x) { return x * rcp_(1.0f + __expf(-x)); }
__device__ __forceinline__ float gelu_tanh(float x) { const float u = 0.7978845608028654f * (x + 0.044715f * x * x * x); return x * rcp_(1.0f + __expf(-2.0f * u)); }
__device__ __forceinline__ unsigned ld_agent(const unsigned* p) { return __hip_atomic_load(p, __ATOMIC_RELAXED, __HIP_MEMORY_SCOPE_AGENT); }

__device__ __forceinline__ void unpack8(float (&o)[8], const v4u x) {
    const unsigned a[4] = {x.x, x.y, x.z, x.w};
#pragma unroll
    for (int k = 0; k < 4; ++k) { o[2 * k] = __builtin_bit_cast(float, a[k] << 16); o[2 * k + 1] = __builtin_bit_cast(float, a[k] & 0xffff0000u); }
}
#define XB_TMO      128
#define XB_XCNT(j)  (256  + 64 * (j))
#define XB_XSUB(j)  (1280 + 64 * (j))
#define XB_XGEN(j)  (2304 + 64 * (j))
#define XB_TOP      3328
#define XB_TOPGEN   3392
#define XCD_BAR_WORDS 3456
#define XB_SPIN_CAP (1u << 21)
__device__ __forceinline__ unsigned xb_ld(unsigned* p)              { return __hip_atomic_load(p, __ATOMIC_RELAXED, __HIP_MEMORY_SCOPE_AGENT); }
__device__ __forceinline__ unsigned xb_add(unsigned* p, unsigned v) { return __hip_atomic_fetch_add(p, v, __ATOMIC_RELAXED, __HIP_MEMORY_SCOPE_AGENT); }
__device__ __forceinline__ unsigned xb_xcc_id() { return (unsigned)__builtin_amdgcn_s_getreg((3 << 11) | 20) & 0xFu; }
#define XB_SPIN(cond, bar) do { unsigned _sp = 0; while (cond) { __builtin_amdgcn_s_sleep(1); \
    if ((++_sp & 255u) == 0u) { if (xb_ld(&(bar)[XB_TMO])) break; if (_sp > XB_SPIN_CAP) { atomicAdd(&(bar)[XB_TMO], 1u); break; } } } } while (0)
struct XcdBarrier { unsigned* bar; unsigned x; volatile LAS unsigned* st; };
__device__ __forceinline__ XcdBarrier xcd_barrier_post(unsigned* bar, volatile LAS unsigned* st) {
    XcdBarrier b; b.bar = bar; b.x = xb_xcc_id(); b.st = st;
    if (threadIdx.x == 0) (void)xb_add(&bar[XB_XCNT(b.x)], 1u);
    return b;
}
__device__ __forceinline__ void xcd_barrier_complete(unsigned* bar, unsigned x, unsigned& nloc, unsigned& nx) {
    const unsigned G = gridDim.x * gridDim.y * gridDim.z;
    unsigned sum, cnt, mine, sp = 0u;
    for (;;) {
        sum = 0u; cnt = 0u; mine = 0u;
#pragma unroll
        for (unsigned j = 0; j < 16; ++j) { const unsigned c = xb_ld(&bar[XB_XCNT(j)]); sum += c; cnt += (c > 0u) ? 1u : 0u; mine = (j == x) ? c : mine; }
        if (sum == G) break;
        __builtin_amdgcn_s_sleep(1);
        if ((++sp & 255u) == 0u) { if (xb_ld(&bar[XB_TMO])) break; if (sp > XB_SPIN_CAP) { atomicAdd(&bar[XB_TMO], 1u); break; } }
    }
    nloc = mine > 0u ? mine : 1u; nx = cnt > 0u ? cnt : 1u;
}
__device__ __forceinline__ void xcd_barrier(const XcdBarrier& b) {
    asm volatile("s_waitcnt vmcnt(0)" ::: "memory");
    __syncthreads();
    if (threadIdx.x == 0) {
        unsigned* bar = b.bar;
        __builtin_amdgcn_s_waitcnt(0);
        unsigned nloc = b.st[0], nx = b.st[1];
        if (nloc == 0u) { xcd_barrier_complete(bar, b.x, nloc, nx); b.st[0] = nloc; b.st[1] = nx; }
        const unsigned old = xb_add(&bar[XB_XSUB(b.x)], 1u);
        const unsigned gen = old / nloc;
        if (old + 1u == (gen + 1u) * nloc) {
            __builtin_amdgcn_fence(__ATOMIC_RELEASE, "agent");
            asm volatile("s_waitcnt vmcnt(0)" ::: "memory");
            const unsigned og = xb_add(&bar[XB_TOP], 1u);
            const unsigned tg = og / nx;
            if (og + 1u == (tg + 1u) * nx) xb_add(&bar[XB_TOPGEN], 1u);
            else XB_SPIN(xb_ld(&bar[XB_TOPGEN]) == tg, bar);
            __builtin_amdgcn_fence(__ATOMIC_ACQUIRE, "agent");
            xb_add(&bar[XB_XGEN(b.x)], 1u);
            asm volatile("s_waitcnt vmcnt(0)" ::: "memory");
        } else {
            XB_SPIN(xb_ld(&bar[XB_XGEN(b.x)]) == gen, bar);
            __builtin_amdgcn_fence(__ATOMIC_ACQUIRE, "agent");
            asm volatile("s_waitcnt vmcnt(0)" ::: "memory");
        }
    }
    __syncthreads();
}

struct Args { const float* in[28]; float* out; unsigned char* ws; unsigned long long dup; int ph_lo, ph_hi; };
struct InTab { __device__ __forceinline__ const float* operator[](int i) const {
    return ((const float* const volatile __attribute__((address_space(4)))*)__builtin_amdgcn_kernarg_segment_ptr())[i]; } };
struct Ctx {
    InTab in; float* out; unsigned char* ws; LAS unsigned char* lds;
    int tid, lane, wave, G, bid;
};
enum { I_X = 0, I_META, I_ABNORM, I_ABWIN, I_CONVW, I_CONVB, I_WR, I_BR, I_WI, I_BI, I_LAM, I_WGK, I_BGK, I_GLANORM, I_ABWOUT,
       I_FFNNORM, I_FFNG, I_FFNU, I_FFND, I_CNORM, I_CWIN, I_CWOUT, I_MOENORM, I_ROUTER, I_MOEG, I_MOEU, I_MOED, I_FINALNORM };

__device__ __forceinline__ int row_of(int b, int t) { return t < NMETA ? MS + t : b * SEQ + (t - NMETA); }

namespace gm {
#ifndef GM_WGM
#define GM_WGM 4
#endif
constexpr int BM = 256, BK = 64, HALF = 128, HTB = HALF * BK * 2, STAGE_BYTES = 8 * HTB, NXCD = 8, WGM = GM_WGM;
__device__ __forceinline__ int lds_byte(int r, int c) { const int st = (r >> 4) * 2 + (c >> 5), rr = r & 15, cc = c & 31, ob = rr * 64 + cc * 2; return st * 1024 + (ob ^ (((ob >> 9) & 1) << 5)); }
__device__ __forceinline__ void stage_rc(int b, int& R, int& C) { const int st = b / 1024, sb = b % 1024, swz = sb ^ (((sb >> 9) & 1) << 5); R = (st >> 1) * 16 + swz / 64; C = (st & 1) * 32 + (swz % 64) / 2; }
__device__ __forceinline__ int perm32(int rho) { const int n = rho >> 4, i = rho & 15; return 8 * (i >> 2) + 4 * n + (i & 3); }
struct Unit { int pm, pn, aux; };
__device__ __forceinline__ bool tile_from_l(long L, int nM, int nN, int& pm, int& pn) {
    const int nwg = nM * nN; if (L >= nwg) return false;
    int wgid = (int)L; { const int q = nwg / NXCD, r = nwg % NXCD, xcd = wgid % NXCD, off = wgid / NXCD; wgid = (xcd < r ? xcd * (q + 1) : r * (q + 1) + (xcd - r) * q) + off; }
    const int nig = WGM * nN, gid = wgid / nig, fm = gid * WGM, gsz = (nM - fm) < WGM ? (nM - fm) : WGM;
    pm = fm + ((wgid % nig) % gsz); pn = (wgid % nig) / gsz; return true;
}
__device__ __forceinline__ bool tile_order(int i, int G, int c, int nM, int nN, int& pm, int& pn) { return tile_from_l((long)i * G + c, nM, nN, pm, pn); }
struct DenseSched {
    int nM, nN, G, c; const char* A; const char* B; unsigned lda, ldb; int gate_mode;
    __device__ __forceinline__ bool next(int i, Unit& u) const { u.aux = 0; return tile_order(i, G, c, nM, nN, u.pm, u.pn); }
    __device__ __forceinline__ const char* a_ptr(const Unit& u) const { return A + (size_t)u.pm * 256 * lda + (gate_mode ? (size_t)(u.pn >> 1) * 512 : 0); }
    __device__ __forceinline__ const char* b_ptr(const Unit& u) const { return B + (size_t)u.pn * 256 * ldb; }
};
struct MoeSched {
    int nM, nN, G, c; const char* A; unsigned lda; int a_tile0; const char* B; unsigned ldb; size_t bexp; const unsigned* tile_expert; int t0;
    int rb = 0, sk = 0;
    __device__ __forceinline__ bool next(int i, Unit& u) const {
        long L = (long)i * G + c;
        if (sk > 0) { int rhi = (nM * nN - sk * (G - rb)) / G; rhi = rhi < 0 ? 0 : rhi;
            if (i >= rhi) { if (c < rb) return false; L = (long)rhi * G + (long)(i - rhi) * (G - rb) + (c - rb); } }
        if (!tile_from_l(L, nM, nN, u.pm, u.pn)) return false;
        u.aux = (int)__builtin_amdgcn_readfirstlane(ld_agent(tile_expert + t0 + u.pm)) & 7; return true; }
    __device__ __forceinline__ const char* a_ptr(const Unit& u) const { return A + (size_t)(a_tile0 + u.pm) * 256 * lda; }
    __device__ __forceinline__ const char* b_ptr(const Unit& u) const { return B + (size_t)u.aux * bexp + (size_t)u.pn * 256 * ldb; }
};

struct EpiBf16 {
    static constexpr bool PERM = true;
    bf16* O; int ldc; int row_off; float s = 1.0f;
    __device__ __forceinline__ void operator()(const f32x4 (&acc)[2][2][4][2], const Unit& u, int wr, int wc, int fr, int fq) const {
        const int row0 = row_off + u.pm * BM + wr * 64 + fr, col0 = u.pn * BM + wc * 32 + 8 * fq;
#pragma unroll
        for (int ai = 0; ai < 2; ++ai)
#pragma unroll
            for (int m = 0; m < 4; ++m) { bf16* rowp = O + (size_t)(row0 + ai * HALF + m * 16) * ldc + col0;
#pragma unroll
                for (int bj = 0; bj < 2; ++bj) { const f32x4 v0 = acc[ai][bj][m][0] * s, v1 = acc[ai][bj][m][1] * s;
                    v4u w; w.x = pk2(v0[0], v0[1]); w.y = pk2(v0[2], v0[3]); w.z = pk2(v1[0], v1[1]); w.w = pk2(v1[2], v1[3]);
                    *(v4u*)(rowp + bj * HALF) = w; } }
    }
};
struct EpiBf16I8 {
    static constexpr bool PERM = true;
    bf16* O; int ldc; const float* xs; const float* wsc;
    __device__ __forceinline__ void operator()(const f32x4 (&acc)[2][2][4][2], const Unit& u, int wr, int wc, int fr, int fq) const {
        const int row0 = u.pm * BM + wr * 64 + fr, col0 = u.pn * BM + wc * 32 + 8 * fq;
        f32x4 cs[2][2];
#pragma unroll
        for (int bj = 0; bj < 2; ++bj) { cs[bj][0] = *(const f32x4*)(wsc + col0 + bj * HALF); cs[bj][1] = *(const f32x4*)(wsc + col0 + bj * HALF + 4); }
#pragma unroll
        for (int ai = 0; ai < 2; ++ai)
#pragma unroll
            for (int m = 0; m < 4; ++m) { const int row = row0 + ai * HALF + m * 16; const float rs = xs[row]; bf16* rowp = O + (size_t)row * ldc + col0;
#pragma unroll
                for (int bj = 0; bj < 2; ++bj) { const v4i_t i0 = __builtin_bit_cast(v4i_t, acc[ai][bj][m][0]), i1 = __builtin_bit_cast(v4i_t, acc[ai][bj][m][1]);
                    float o[8];
#pragma unroll
                    for (int j = 0; j < 4; ++j) { o[j] = (float)i0[j] * rs * cs[bj][0][j]; o[4 + j] = (float)i1[j] * rs * cs[bj][1][j]; }
                    v4u w; w.x = pk2(o[0], o[1]); w.y = pk2(o[2], o[3]); w.z = pk2(o[4], o[5]); w.w = pk2(o[6], o[7]);
                    *(v4u*)(rowp + bj * HALF) = w; } }
    }
};
struct EpiSwigluI8 {
    static constexpr bool PERM = true;
    unsigned char* O; int ldc; const float* xs; const float* wsc;
    __device__ __forceinline__ void operator()(const f32x4 (&acc)[2][2][4][2], const Unit& u, int wr, int wc, int fr, int fq) const {
        const int row0 = u.pm * BM + wr * 64 + fr, col0 = u.pn * HALF + wc * 32 + 8 * fq, wrow0 = u.pn * BM + wc * 32 + 8 * fq;
        f32x4 cs[2][2];
#pragma unroll
        for (int bj = 0; bj < 2; ++bj) { cs[bj][0] = *(const f32x4*)(wsc + wrow0 + bj * HALF); cs[bj][1] = *(const f32x4*)(wsc + wrow0 + bj * HALF + 4); }
#pragma unroll
        for (int ai = 0; ai < 2; ++ai)
#pragma unroll
            for (int m = 0; m < 4; ++m) { const int row = row0 + ai * HALF + m * 16; const float rs = xs[row]; unsigned char* rowp = O + (size_t)row * ldc + col0;
                float o[8];
#pragma unroll
                for (int n = 0; n < 2; ++n) { const v4i_t ig = __builtin_bit_cast(v4i_t, acc[ai][0][m][n]), iu = __builtin_bit_cast(v4i_t, acc[ai][1][m][n]);
#pragma unroll
                    for (int j = 0; j < 4; ++j) o[4 * n + j] = siluf_((float)ig[j] * rs * cs[0][n][j]) * ((float)iu[j] * rs * cs[1][n][j]); }
                v2u w; w.x = f8x4(o[0], o[1], o[2], o[3]); w.y = f8x4(o[4], o[5], o[6], o[7]);
                *(v2u*)rowp = w; }
    }
};
struct EpiSwigluF8 {
    static constexpr bool PERM = true;
    unsigned char* O; int ldc; float s;
    __device__ __forceinline__ void operator()(const f32x4 (&acc)[2][2][4][2], const Unit& u, int wr, int wc, int fr, int fq) const {
        const int row0 = u.pm * BM + wr * 64 + fr, col0 = u.pn * HALF + wc * 32 + 8 * fq;
#pragma unroll
        for (int ai = 0; ai < 2; ++ai)
#pragma unroll
            for (int m = 0; m < 4; ++m) { unsigned char* rowp = O + (size_t)(row0 + ai * HALF + m * 16) * ldc + col0;
                float o[8];
#pragma unroll
                for (int n = 0; n < 2; ++n)
#pragma unroll
                    for (int j = 0; j < 4; ++j) o[4 * n + j] = siluf_(acc[ai][0][m][n][j] * s) * (acc[ai][1][m][n][j] * s);
                v2u w; w.x = f8x4(o[0], o[1], o[2], o[3]); w.y = f8x4(o[4], o[5], o[6], o[7]);
                *(v2u*)rowp = w; }
    }
};
struct EpiSwiglu {
    static constexpr bool PERM = true;
    bf16* O; int ldc;
    __device__ __forceinline__ void operator()(const f32x4 (&acc)[2][2][4][2], const Unit& u, int wr, int wc, int fr, int fq) const {
        const int row0 = u.pm * BM + wr * 64 + fr, col0 = u.pn * HALF + wc * 32 + 8 * fq;
#pragma unroll
        for (int ai = 0; ai < 2; ++ai)
#pragma unroll
            for (int m = 0; m < 4; ++m) { bf16* rowp = O + (size_t)(row0 + ai * HALF + m * 16) * ldc + col0;
                float o[8];
#pragma unroll
                for (int n = 0; n < 2; ++n)
#pragma unroll
                    for (int j = 0; j < 4; ++j) o[4 * n + j] = siluf_(acc[ai][0][m][n][j]) * acc[ai][1][m][n][j];
                v4u w; w.x = pk2(o[0], o[1]); w.y = pk2(o[2], o[3]); w.z = pk2(o[4], o[5]); w.w = pk2(o[6], o[7]);
                *(v4u*)rowp = w; }
    }
};
struct EpiResid {
    static constexpr bool PERM = true;
    const float* src; bf16* hb; float* hmpad; float sc = 1.0f;
    __device__ __forceinline__ void operator()(const f32x4 (&acc)[2][2][4][2], const Unit& u, int wr, int wc, int fr, int fq) const {
        const bool meta = (u.pm == 128);
        const int row0 = (meta ? 0 : u.pm * BM) + wr * 64 + fr, col0 = u.pn * BM + wc * 32 + 8 * fq;
#pragma unroll
        for (int ai = 0; ai < 2; ++ai)
#pragma unroll
            for (int m = 0; m < 4; ++m) { const size_t ro = (size_t)(row0 + ai * HALF + m * 16) * D + col0;
#pragma unroll
                for (int bj = 0; bj < 2; ++bj) { const size_t o = ro + bj * HALF;
                    if (meta) { *(f32x4*)(hmpad + o) = *(const f32x4*)(hmpad + o) + acc[ai][bj][m][0] * sc; *(f32x4*)(hmpad + o + 4) = *(const f32x4*)(hmpad + o + 4) + acc[ai][bj][m][1] * sc; }
                    else { f32x4 s0, s1;
                        if (src) { s0 = *(const f32x4*)(src + o); s1 = *(const f32x4*)(src + o + 4); }
                        else { const v4u w = *(const v4u*)(hb + o);
                            s0.x = __builtin_bit_cast(float, w.x << 16); s0.y = __builtin_bit_cast(float, w.x & 0xffff0000u); s0.z = __builtin_bit_cast(float, w.y << 16); s0.w = __builtin_bit_cast(float, w.y & 0xffff0000u);
                            s1.x = __builtin_bit_cast(float, w.z << 16); s1.y = __builtin_bit_cast(float, w.z & 0xffff0000u); s1.z = __builtin_bit_cast(float, w.w << 16); s1.w = __builtin_bit_cast(float, w.w & 0xffff0000u); }
                        const f32x4 r0 = s0 + acc[ai][bj][m][0] * sc, r1 = s1 + acc[ai][bj][m][1] * sc;
                        v4u ow; ow.x = pk2(r0.x, r0.y); ow.y = pk2(r0.z, r0.w); ow.z = pk2(r1.x, r1.y); ow.w = pk2(r1.z, r1.w); *(v4u*)(hb + o) = ow; } } }
    }
};

template <class Epi, class Sched, int MODE = 0>
__device__ __forceinline__ void gemm_phase(LAS unsigned char* lds, const Sched& S, const Epi& E, const int nt, const unsigned lda, const unsigned ldb) {
    const int tid = threadIdx.x, wid = __builtin_amdgcn_readfirstlane(tid >> 6), lane = tid & 63, wr = wid >> 2, wc = wid & 3, fr = lane & 15, fq = lane >> 4;
    unsigned voffA[2], voffB[2];
#pragma unroll
    for (int i = 0; i < 2; ++i) { int R, C; stage_rc(tid * 16 + i * 8192, R, C); const int Rb = Epi::PERM ? ((R & ~31) + perm32(R & 31)) : R;
        voffA[i] = (unsigned)R * lda + (unsigned)C * 2u; voffB[i] = (unsigned)Rb * ldb + (unsigned)C * 2u; }
    const size_t kstep = (size_t)(BK * 2);
    const size_t hstepA = (size_t)HALF * lda, hstepB = (size_t)HALF * ldb;
    const unsigned ldsw = (unsigned)wid * 1024u;
    const int aoff = lds_byte(wr * 64 + fr, fq * 8), boff = lds_byte(wc * 32 + fr, fq * 8);
#define PG8_SA(b, h) (((b) * 2 + (h)) * HTB)
#define PG8_SB(b, h) ((4 + (b) * 2 + (h)) * HTB)
#define PG8_STAGE(bufoff, gbase, voff) do { _Pragma("unroll") for (int _i = 0; _i < 2; ++_i) \
        __builtin_amdgcn_global_load_lds((const unsigned*)((const char*)(gbase) + (voff)[_i]), (LAS unsigned*)(lds + (bufoff) + ldsw + _i * 8192), 16, 0, 0); } while (0)
#define PG8_LDA(dst, b, h) do { _Pragma("unroll") for (int m = 0; m < 4; ++m) { if constexpr (MODE == 1) { dst##8[m].lo = *(const LAS v4i_t*)(lds + PG8_SA(b, h) + aoff + m * 2048); dst##8[m].hi = *(const LAS v4i_t*)(lds + PG8_SA(b, h) + aoff + m * 2048 + 1024); } \
        else { _Pragma("unroll") for (int k = 0; k < 2; ++k) dst[m][k] = *(const LAS bf16x8*)(lds + PG8_SA(b, h) + aoff + m * 2048 + k * 1024); } } } while (0)
#define PG8_LDB(dst, b, h) do { _Pragma("unroll") for (int n = 0; n < 2; ++n) { if constexpr (MODE == 1) { dst##8[n].lo = *(const LAS v4i_t*)(lds + PG8_SB(b, h) + boff + n * 2048); dst##8[n].hi = *(const LAS v4i_t*)(lds + PG8_SB(b, h) + boff + n * 2048 + 1024); } \
        else { _Pragma("unroll") for (int k = 0; k < 2; ++k) dst[n][k] = *(const LAS bf16x8*)(lds + PG8_SB(b, h) + boff + n * 2048 + k * 1024); } } } while (0)
#define PG8_MMA(ai, bj, At, Bt) do { __builtin_amdgcn_s_setprio(1); _Pragma("unroll") for (int m = 0; m < 4; ++m) _Pragma("unroll") for (int n = 0; n < 2; ++n) { \
        if constexpr (MODE == 1) asm volatile("v_mfma_scale_f32_16x16x128_f8f6f4 %0, %1, %2, %0, %3, %3 op_sel_hi:[0,0,0]" : "+v"(acc[ai][bj][m][n]) : "v"(Bt##8[n]), "v"(At##8[m]), "v"(f8scale)); \
        else if constexpr (MODE == 2) { _Pragma("unroll") for (int k = 0; k < 2; ++k) acc[ai][bj][m][n] = __builtin_bit_cast(f32x4, __builtin_amdgcn_mfma_i32_16x16x64_i8(__builtin_bit_cast(v4i_t, Bt[n][k]), __builtin_bit_cast(v4i_t, At[m][k]), __builtin_bit_cast(v4i_t, acc[ai][bj][m][n]), 0, 0, 0)); } \
        else { _Pragma("unroll") for (int k = 0; k < 2; ++k) acc[ai][bj][m][n] = __builtin_amdgcn_mfma_f32_16x16x32_bf16(Bt[n][k], At[m][k], acc[ai][bj][m][n], 0, 0, 0); } } \
        __builtin_amdgcn_s_setprio(0); } while (0)
#define PG8_WAIT_V(n) asm volatile("s_waitcnt vmcnt(" #n ")" ::: "memory")
#define PG8_WAIT_L(n) asm volatile("s_waitcnt lgkmcnt(" #n ")" ::: "memory")
#define PG8_BAR __builtin_amdgcn_s_barrier()
#define PG8_SCHED __builtin_amdgcn_sched_barrier(0)
    Unit cur, nxt; int ui = 0;
    if (!S.next(0, cur)) return;
    f32x4 acc[2][2][4][2];
#pragma unroll
    for (int a = 0; a < 2; ++a)
#pragma unroll
        for (int b = 0; b < 2; ++b)
#pragma unroll
            for (int m = 0; m < 4; ++m)
#pragma unroll
                for (int n = 0; n < 2; ++n) acc[a][b][m][n] = (f32x4){0.f, 0.f, 0.f, 0.f};
    const int f8scale = 0x7F7F7F7F;
    bf16x8 At[4][2], B0[2][2], B1[2][2]; v8i_t At8[4], B08[2], B18[2];
    const char* cA = S.a_ptr(cur); const char* cB = S.b_ptr(cur);
    PG8_STAGE(PG8_SB(0, 0), cB, voffB); PG8_STAGE(PG8_SA(0, 0), cA, voffA); PG8_STAGE(PG8_SB(0, 1), cB + hstepB, voffB); PG8_STAGE(PG8_SA(0, 1), cA + hstepA, voffA);
    if (wr == 1) PG8_BAR;
    PG8_WAIT_V(4); PG8_BAR;
    PG8_STAGE(PG8_SB(1, 0), cB + kstep, voffB); PG8_STAGE(PG8_SA(1, 0), cA + kstep, voffA); PG8_STAGE(PG8_SB(1, 1), cB + hstepB + kstep, voffB);
    PG8_WAIT_V(6); PG8_BAR;
    for (;;) {
        const bool has_next = S.next(ui + 1, nxt);
        const char* nA = has_next ? S.a_ptr(nxt) : cA; const char* nB = has_next ? S.b_ptr(nxt) : cB;
        for (int t = 0; t < nt; t += 2) {
            const bool last = (t == nt - 2);
            const char* a1 = cA + (size_t)(t + 1) * kstep;
            const char* a2 = last ? nA : cA + (size_t)(t + 2) * kstep; const char* b2 = last ? nB : cB + (size_t)(t + 2) * kstep;
            const char* a3 = a2 + kstep; const char* b3 = b2 + kstep;
            PG8_LDB(B0, 0, 0); PG8_SCHED; PG8_LDA(At, 0, 0); PG8_STAGE(PG8_SA(1, 1), a1 + hstepA, voffA);
            PG8_WAIT_L(8); PG8_BAR; PG8_WAIT_L(0); PG8_MMA(0, 0, At, B0); PG8_BAR; PG8_SCHED;
            PG8_LDB(B1, 0, 1); PG8_STAGE(PG8_SB(0, 0), b2, voffB);
            PG8_BAR; PG8_WAIT_L(0); PG8_MMA(0, 1, At, B1); PG8_BAR;
            PG8_LDA(At, 0, 1); PG8_STAGE(PG8_SA(0, 0), a2, voffA);
            PG8_BAR; PG8_WAIT_L(0); PG8_MMA(1, 0, At, B0); PG8_BAR; PG8_SCHED;
            PG8_STAGE(PG8_SB(0, 1), b2 + hstepB, voffB);
            PG8_WAIT_V(6); PG8_BAR; PG8_MMA(1, 1, At, B1); PG8_BAR;
            PG8_LDB(B0, 1, 0); PG8_SCHED; PG8_LDA(At, 1, 0); PG8_STAGE(PG8_SA(0, 1), a2 + hstepA, voffA);
            PG8_WAIT_L(8); PG8_BAR; PG8_WAIT_L(0); PG8_MMA(0, 0, At, B0); PG8_BAR; PG8_SCHED;
            PG8_LDB(B1, 1, 1); PG8_STAGE(PG8_SB(1, 0), b3, voffB);
            PG8_BAR; PG8_WAIT_L(0); PG8_MMA(0, 1, At, B1); PG8_BAR;
            PG8_LDA(At, 1, 1); PG8_STAGE(PG8_SA(1, 0), a3, voffA);
            PG8_BAR; PG8_WAIT_L(0); PG8_MMA(1, 0, At, B0); PG8_BAR; PG8_SCHED;
            PG8_STAGE(PG8_SB(1, 1), b3 + hstepB, voffB);
            PG8_WAIT_V(6); PG8_BAR; PG8_MMA(1, 1, At, B1); PG8_BAR;
        }
        if constexpr (MODE == 1) asm volatile("s_nop 15\n\ts_nop 3" ::: "memory");
#if defined(EPI_PROBE)
        { volatile LAS unsigned* misc_ = (volatile LAS unsigned*)(lds + (158720 - 0)); const bool on_ = (blockIdx.x == 0 && tid == 0);
          unsigned long long t_ = 0; if (on_) t_ = __builtin_amdgcn_s_memrealtime();
          E(acc, cur, wr, wc, fr, fq);
          asm volatile("s_waitcnt vmcnt(0)" ::: "memory");
          if (on_) { const unsigned long long d_ = __builtin_amdgcn_s_memrealtime() - t_; const unsigned long long a_ = ((unsigned long long)misc_[18] | ((unsigned long long)misc_[19] << 32)) + d_; misc_[18] = (unsigned)a_; misc_[19] = (unsigned)(a_ >> 32); } }
#else
        E(acc, cur, wr, wc, fr, fq);
#endif
        if (!has_next) break;
#pragma unroll
        for (int a = 0; a < 2; ++a)
#pragma unroll
            for (int b = 0; b < 2; ++b)
#pragma unroll
                for (int m = 0; m < 4; ++m)
#pragma unroll
                    for (int n = 0; n < 2; ++n) acc[a][b][m][n] = (f32x4){0.f, 0.f, 0.f, 0.f};
        cur = nxt; cA = nA; cB = nB; ++ui;
    }
    PG8_WAIT_V(0);
    if (wr == 0) PG8_BAR;
    PG8_BAR;
#undef PG8_SA
#undef PG8_SB
#undef PG8_STAGE
#undef PG8_LDA
#undef PG8_LDB
#undef PG8_MMA
#undef PG8_WAIT_V
#undef PG8_WAIT_L
#undef PG8_BAR
#undef PG8_SCHED
}
}

__device__ __forceinline__ void tr_item_f8(const float* src, int ldsrc, int c0, int nvalid, unsigned char* dst8, int K, int r0, int k0, float wscale, LAS float* scr, int lane) {
    const int kr = lane >> 4, cq = (lane & 15) * 4;
    f32x4 v[16];
    const float* sp = src + (size_t)(k0 + kr) * ldsrc + c0 + cq;
    if (cq < nvalid) {
#pragma unroll
        for (int i = 0; i < 16; ++i) v[i] = __builtin_nontemporal_load((const f32x4*)(sp + (size_t)(4 * i) * ldsrc));
    } else {
#pragma unroll
        for (int i = 0; i < 16; ++i) v[i] = (f32x4){0.f, 0.f, 0.f, 0.f};
    }
#pragma unroll
    for (int i = 0; i < 16; ++i) { LAS float* d = scr + (4 * i + kr) * 65 + cq; d[0] = v[i].x; d[1] = v[i].y; d[2] = v[i].z; d[3] = v[i].w; }
    LDS_WAIT();
    const int c = lane & 7;
#pragma unroll
    for (int j = 0; j < 8; ++j) { const int n = (lane >> 3) + 8 * j; const LAS float* s = scr + (8 * c) * 65 + n;
        v2u o; o.x = f8x4(s[0 * 65] * wscale, s[1 * 65] * wscale, s[2 * 65] * wscale, s[3 * 65] * wscale); o.y = f8x4(s[4 * 65] * wscale, s[5 * 65] * wscale, s[6 * 65] * wscale, s[7 * 65] * wscale);
        *(v2u*)(dst8 + (size_t)(r0 + n) * K + k0 + 8 * c) = o; }
    LDS_WAIT();
}
__device__ __forceinline__ void tr_item(const float* src, int ldsrc, int c0, int nvalid, bf16* dst, int K, int r0, int k0, LAS float* scr, int lane) {
    const int kr = lane >> 4, cq = (lane & 15) * 4;
    f32x4 v[16];
    const float* sp = src + (size_t)(k0 + kr) * ldsrc + c0 + cq;
    if (cq < nvalid) {
#pragma unroll
        for (int i = 0; i < 16; ++i) v[i] = __builtin_nontemporal_load((const f32x4*)(sp + (size_t)(4 * i) * ldsrc));
    } else {
#pragma unroll
        for (int i = 0; i < 16; ++i) v[i] = (f32x4){0.f, 0.f, 0.f, 0.f};
    }
#pragma unroll
    for (int i = 0; i < 16; ++i) { LAS float* d = scr + (4 * i + kr) * 65 + cq; d[0] = v[i].x; d[1] = v[i].y; d[2] = v[i].z; d[3] = v[i].w; }
    LDS_WAIT();
    const int c = lane & 7;
#pragma unroll
    for (int j = 0; j < 8; ++j) { const int n = (lane >> 3) + 8 * j; const LAS float* s = scr + (8 * c) * 65 + n;
        v4u o; o.x = pk2(s[0 * 65], s[1 * 65]); o.y = pk2(s[2 * 65], s[3 * 65]); o.z = pk2(s[4 * 65], s[5 * 65]); o.w = pk2(s[6 * 65], s[7 * 65]);
        *(v4u*)(dst + (size_t)(r0 + n) * K + k0 + 8 * c) = o; }
    LDS_WAIT();
}
__device__ __forceinline__ unsigned i8x4(float a, float b, float c, float d) {
    const int ia = (int)__builtin_rintf(a), ib = (int)__builtin_rintf(b), ic = (int)__builtin_rintf(c), id = (int)__builtin_rintf(d);
    return (unsigned)(ia & 0xff) | ((unsigned)(ib & 0xff) << 8) | ((unsigned)(ic & 0xff) << 16) | ((unsigned)id << 24);
}
struct I8Mat { const float* src; int N, nsg_src, nsg_dst, mode, off; unsigned char* dst; };
__device__ __forceinline__ I8Mat i8_mat(const Ctx& c, int m) {
    I8Mat t;
    if (m == 0) { t.src = c.in[I_ABWIN]; t.N = NAB; t.nsg_src = 81; t.nsg_dst = NABP / 64; t.mode = 0; t.off = WMX_AB; t.dst = c.ws + WS_WINAB; }
    else if (m == 1) { t.src = c.in[I_FFNG]; t.N = DFF; t.nsg_src = 88; t.nsg_dst = 88; t.mode = 1; t.off = WMX_GU; t.dst = c.ws + WS_WGU; }
    else if (m == 2) { t.src = c.in[I_FFNU]; t.N = DFF; t.nsg_src = 88; t.nsg_dst = 88; t.mode = 2; t.off = WMX_GU; t.dst = c.ws + WS_WGU; }
    else { t.src = c.in[I_CWIN]; t.N = NC; t.nsg_src = 58; t.nsg_dst = NCP / 64; t.mode = 0; t.off = WMX_C; t.dst = c.ws + WS_WINC; }
    return t;
}
__device__ __forceinline__ int i8_dstgroup(int mode, int sg) { return mode == 0 ? sg : ((sg >> 1) * 4 + (mode == 2 ? 2 : 0) + (sg & 1)); }
__device__ __forceinline__ void ph_colmax(const Ctx& c) {
    unsigned* WMAX = (unsigned*)(c.ws + WS_CTL) + CW_WMAX;
    const int gw = c.bid * 8 + c.wave, NGW = c.G * 8, lane = c.lane, rr = lane >> 4, cq = (lane & 15) * 4;
    for (int it = gw; it < (81 + 88 + 88 + 58) * 16; it += NGW) {
        int r = it >> 4; const int kq = it & 15; int m = 0;
        if (r >= 81) { r -= 81; m = 1; if (r >= 88) { r -= 88; m = 2; if (r >= 88) { r -= 88; m = 3; } } }
        const I8Mat t = i8_mat(c, m); const int col = 64 * r + cq;
        f32x4 mx = (f32x4){0.f, 0.f, 0.f, 0.f};
        if (col < t.N) { const float* p = t.src + (size_t)(kq * 128 + rr) * t.N + col;
#pragma unroll 1
            for (int k0 = 0; k0 < 32; k0 += 16) { f32x4 v[16];
#pragma unroll
                for (int k = 0; k < 16; ++k) v[k] = __builtin_nontemporal_load((const f32x4*)(p + (size_t)(4 * (k0 + k)) * t.N));
#pragma unroll
                for (int k = 0; k < 16; ++k) { mx.x = fmaxf(mx.x, fabsf(v[k].x)); mx.y = fmaxf(mx.y, fabsf(v[k].y)); mx.z = fmaxf(mx.z, fabsf(v[k].z)); mx.w = fmaxf(mx.w, fabsf(v[k].w)); } } }
        mx.x = fmaxf(mx.x, __shfl_xor(mx.x, 16)); mx.y = fmaxf(mx.y, __shfl_xor(mx.y, 16)); mx.z = fmaxf(mx.z, __shfl_xor(mx.z, 16)); mx.w = fmaxf(mx.w, __shfl_xor(mx.w, 16));
        mx.x = fmaxf(mx.x, __shfl_xor(mx.x, 32)); mx.y = fmaxf(mx.y, __shfl_xor(mx.y, 32)); mx.z = fmaxf(mx.z, __shfl_xor(mx.z, 32)); mx.w = fmaxf(mx.w, __shfl_xor(mx.w, 32));
        if (col < t.N && rr == 0) {
            unsigned* wp = WMAX + t.off + 64 * i8_dstgroup(t.mode, r) + cq;
            const float m0 = mx.x, m1 = mx.y, m2 = mx.z, m3 = mx.w;
            __hip_atomic_fetch_max(wp + 0, __builtin_bit_cast(unsigned, m0), __ATOMIC_RELAXED, __HIP_MEMORY_SCOPE_AGENT); __hip_atomic_fetch_max(wp + 1, __builtin_bit_cast(unsigned, m1), __ATOMIC_RELAXED, __HIP_MEMORY_SCOPE_AGENT);
            __hip_atomic_fetch_max(wp + 2, __builtin_bit_cast(unsigned, m2), __ATOMIC_RELAXED, __HIP_MEMORY_SCOPE_AGENT); __hip_atomic_fetch_max(wp + 3, __builtin_bit_cast(unsigned, m3), __ATOMIC_RELAXED, __HIP_MEMORY_SCOPE_AGENT); }
    }
}
__device__ __forceinline__ void tr_item_i8(const float* src, int ldsrc, int c0, int nvalid, unsigned char* dst8, int K, int r0, int k0, const unsigned* wmax, float* wsc, LAS float* scr, int lane) {
    const int kr = lane >> 4, cq = (lane & 15) * 4;
    f32x4 v[16];
    { const float* sp0 = src + (size_t)(k0 + kr) * ldsrc + c0 + cq;
      if (cq < nvalid) {
#pragma unroll
          for (int i = 0; i < 16; ++i) v[i] = __builtin_nontemporal_load((const f32x4*)(sp0 + (size_t)(4 * i) * ldsrc));
      } else {
#pragma unroll
          for (int i = 0; i < 16; ++i) v[i] = (f32x4){0.f, 0.f, 0.f, 0.f};
      } }
#pragma unroll
    for (int i = 0; i < 16; ++i) { LAS float* d = scr + (4 * i + kr) * 65 + cq; d[0] = v[i].x; d[1] = v[i].y; d[2] = v[i].z; d[3] = v[i].w; }
    LDS_WAIT();
    const int cch = lane & 7;
#pragma unroll
    for (int j = 0; j < 8; ++j) { const int n = (lane >> 3) + 8 * j; const LAS float* sp = scr + (8 * cch) * 65 + n;
        const float mx = __builtin_bit_cast(float, ld_agent(wmax + r0 + n)); const float inv = mx > 0.f ? 127.0f / mx : 0.f;
        v2u o; o.x = i8x4(sp[0 * 65] * inv, sp[1 * 65] * inv, sp[2 * 65] * inv, sp[3 * 65] * inv); o.y = i8x4(sp[4 * 65] * inv, sp[5 * 65] * inv, sp[6 * 65] * inv, sp[7 * 65] * inv);
        *(v2u*)(dst8 + (size_t)(r0 + n) * K + k0 + 8 * cch) = o;
        if (k0 == 0 && cch == 0) wsc[r0 + n] = mx > 0.f ? mx * (1.0f / 127.0f) : 1.0f; }
    LDS_WAIT();
}
__device__ __forceinline__ void ph_pre2(const Ctx& c) {
    LAS float* scr = (LAS float*)(c.lds + c.wave * 16640);
    const unsigned* WMAX = (const unsigned*)(c.ws + WS_CTL) + CW_WMAX; float* WSC = (float*)(c.ws + WS_WSC);
    const int gw = c.bid * 8 + c.wave, NGW = c.G * 8;
    for (int it = gw; it < (84 + 88 + 88 + 60) * 32; it += NGW) {
        int r = it >> 5; const int kb = it & 31; int m = 0;
        if (r >= 84) { r -= 84; m = 1; if (r >= 88) { r -= 88; m = 2; if (r >= 88) { r -= 88; m = 3; } } }
        const I8Mat t = i8_mat(c, m);
        int nv = t.N - 64 * r; nv = nv < 0 ? 0 : (nv > 64 ? 64 : nv);
        tr_item_i8(t.src, t.N, 64 * r, nv, t.dst, D, 64 * i8_dstgroup(t.mode, r), 64 * kb, WMAX + t.off, WSC + t.off, scr, c.lane);
    }
}
struct TJob { const float* src; bf16* dst; int N, K, nsg, mode; float f8s; };
__device__ __forceinline__ void run_job_item(const TJob& j, int item, LAS float* scr, int lane) {
    const int nkb = j.K / 64, sg = item / nkb, kb = item % nkb;
    int nv = j.N - 64 * sg; nv = nv < 0 ? 0 : (nv > 64 ? 64 : nv);
    const int dg = j.mode == 0 ? sg : ((sg >> 1) * 4 + (j.mode == 2 ? 2 : 0) + (sg & 1));
    if (j.f8s != 0.f) tr_item_f8(j.src, j.N, 64 * sg, nv, (unsigned char*)j.dst, j.K, 64 * dg, 64 * kb, j.f8s, scr, lane);
    else tr_item(j.src, j.N, 64 * sg, nv, j.dst, j.K, 64 * dg, 64 * kb, scr, lane);
}
__device__ __forceinline__ TJob job_l0(const Ctx& c, int j) {
    TJob t; t.mode = 0; t.f8s = 0.f;
    if (j == 0) { t.src = c.in[I_ABWIN]; t.dst = (bf16*)(c.ws + WS_WINAB); t.N = NAB; t.K = D; t.nsg = NABP / 64; }
    else if (j <= 4) { const int n = j - 1; t.src = c.in[I_WR] + n * 65536; t.dst = (bf16*)(c.ws + WS_WRI) + (size_t)(n * 512) * 256; t.N = 256; t.K = 256; t.nsg = 4; }
    else if (j <= 8) { const int n = j - 5; t.src = c.in[I_WI] + n * 65536; t.dst = (bf16*)(c.ws + WS_WRI) + (size_t)(n * 512 + 256) * 256; t.N = 256; t.K = 256; t.nsg = 4; }
    else if (j == 9) { t.src = c.in[I_ABWOUT]; t.dst = (bf16*)(c.ws + WS_WOUTAB); t.N = D; t.K = D; t.nsg = 32; if (G3_F8) t.f8s = MOE_WS_GU; }
    else if (j == 10) { t.src = c.in[I_FFNG]; t.dst = (bf16*)(c.ws + WS_WGU); t.N = DFF; t.K = D; t.nsg = 88; t.mode = 1; t.f8s = MOE_WS_GU; }
    else if (j == 11) { t.src = c.in[I_FFNU]; t.dst = (bf16*)(c.ws + WS_WGU); t.N = DFF; t.K = D; t.nsg = 88; t.mode = 2; t.f8s = MOE_WS_GU; }
    else if (j == 12) { t.src = c.in[I_FFND]; t.dst = (bf16*)(c.ws + WS_WDOWN); t.N = D; t.K = DFF; t.nsg = 32; t.f8s = MOE_WS_D; }
    else if (j == 13) { t.src = c.in[I_CWIN]; t.dst = (bf16*)(c.ws + WS_WINC); t.N = NC; t.K = D; t.nsg = NCP / 64; }
    else { t.src = c.in[I_CWOUT]; t.dst = (bf16*)(c.ws + WS_WOUTC); t.N = D; t.K = D; t.nsg = 32; if (G7_F8) t.f8s = MOE_WS_GU; }
    return t;
}
__device__ __forceinline__ TJob job_moe(const Ctx& c, int j) {
    TJob t; const int e = j / 3, k = j % 3;
    if (k == 0) { t.src = c.in[I_MOEG] + (size_t)e * D * DEXP; t.dst = (bf16*)(c.ws + WS_WMGU + (size_t)e * 14336 * D); t.N = DEXP; t.K = D; t.nsg = 112; t.mode = 1; t.f8s = MOE_WS_GU; }
    else if (k == 1) { t.src = c.in[I_MOEU] + (size_t)e * D * DEXP; t.dst = (bf16*)(c.ws + WS_WMGU + (size_t)e * 14336 * D); t.N = DEXP; t.K = D; t.nsg = 112; t.mode = 2; t.f8s = MOE_WS_GU; }
    else { t.src = c.in[I_MOED] + (size_t)e * DEXP * D; t.dst = (bf16*)(c.ws + WS_WMD + (size_t)e * D * DEXP); t.N = D; t.K = DEXP; t.nsg = 32; t.mode = 0; t.f8s = MOE_WS_D; }
    return t;
}
__device__ __forceinline__ void rms_row_bf16(const float* xrow, const float* g, bf16* orow, int lane) {
    const f32x4* xr = (const f32x4*)xrow + lane; f32x4 v[8]; float s = 0.f;
#pragma unroll
    for (int j = 0; j < 8; ++j) { v[j] = xr[64 * j]; s += (v[j].x * v[j].x + v[j].y * v[j].y) + (v[j].z * v[j].z + v[j].w * v[j].w); }
    const float rstd = 1.0f / sqrtf(wave_sum(s) * (1.f / D) + EPS);
    v2u* o8 = (v2u*)orow + lane;
#pragma unroll
    for (int j = 0; j < 8; ++j) { const f32x4 gg = ((const f32x4*)g)[lane + 64 * j]; const f32x4 o = v[j] * rstd * gg; v2u w; w.x = pk2(o.x, o.y); w.y = pk2(o.z, o.w); o8[64 * j] = w; }
}
__device__ __forceinline__ const float* h_row(const Ctx& c, const float* main, int row) {
    return row < MS ? main + (size_t)row * D : (const float*)(c.ws + WS_HMPAD) + (size_t)(row - MS) * D;
}
__device__ __forceinline__ void row_load(f32x4 (&v)[8], const float* xrow, int lane) {
    const f32x4* xr = (const f32x4*)xrow + lane;
#pragma unroll
    for (int j = 0; j < 8; ++j) v[j] = xr[64 * j];
}
__device__ __forceinline__ void row_load_h(f32x4 (&v)[8], const Ctx& c, int row, int lane) {
    if (row < MS) { const v2u* p = (const v2u*)((const bf16*)(c.ws + WS_HB) + (size_t)row * D) + lane;
#pragma unroll
        for (int j = 0; j < 8; ++j) { const v2u w = p[64 * j]; v[j].x = __builtin_bit_cast(float, w.x << 16); v[j].y = __builtin_bit_cast(float, w.x & 0xffff0000u); v[j].z = __builtin_bit_cast(float, w.y << 16); v[j].w = __builtin_bit_cast(float, w.y & 0xffff0000u); } }
    else row_load(v, (const float*)(c.ws + WS_HMPAD) + (size_t)(row - MS) * D, lane);
}
__device__ __forceinline__ void rms_regs_bf16(const f32x4 (&v)[8], const float* g, bf16* orow, int lane) {
    float s = 0.f;
#pragma unroll
    for (int j = 0; j < 8; ++j) s += (v[j].x * v[j].x + v[j].y * v[j].y) + (v[j].z * v[j].z + v[j].w * v[j].w);
    const float rstd = 1.0f / sqrtf(wave_sum(s) * (1.f / D) + EPS);
    v2u* o8 = (v2u*)orow + lane;
#pragma unroll
    for (int j = 0; j < 8; ++j) { const f32x4 gg = ((const f32x4*)g)[lane + 64 * j]; const f32x4 o = v[j] * rstd * gg; v2u w; w.x = pk2(o.x, o.y); w.y = pk2(o.z, o.w); o8[64 * j] = w; }
}
__device__ __forceinline__ void rms_regs_i8(const f32x4 (&v)[8], const float* g, unsigned char* orow, float* xsp, int lane) {
    float s = 0.f;
#pragma unroll
    for (int j = 0; j < 8; ++j) s += (v[j].x * v[j].x + v[j].y * v[j].y) + (v[j].z * v[j].z + v[j].w * v[j].w);
    const float rstd = 1.0f / sqrtf(wave_sum(s) * (1.f / D) + EPS);
    f32x4 o[8]; float mx = 0.f;
#pragma unroll
    for (int j = 0; j < 8; ++j) { const f32x4 gg = ((const f32x4*)g)[lane + 64 * j]; o[j] = v[j] * rstd * gg; mx = fmaxf(mx, fmaxf(fmaxf(fabsf(o[j].x), fabsf(o[j].y)), fmaxf(fabsf(o[j].z), fabsf(o[j].w)))); }
    mx = wave_max(mx); const float inv = mx > 0.f ? 127.0f / mx : 0.f;
    unsigned* o4 = (unsigned*)orow + lane;
#pragma unroll
    for (int j = 0; j < 8; ++j) o4[64 * j] = i8x4(o[j].x * inv, o[j].y * inv, o[j].z * inv, o[j].w * inv);
    if (lane == 0) *xsp = mx > 0.f ? mx * (1.0f / 127.0f) : 1.0f;
}
__device__ __forceinline__ void rms_regs_i8g(const f32x4 (&v)[8], const f32x4 (&gg)[8], unsigned char* orow, float* xsp, int lane) {
    float s = 0.f;
#pragma unroll
    for (int j = 0; j < 8; ++j) s += (v[j].x * v[j].x + v[j].y * v[j].y) + (v[j].z * v[j].z + v[j].w * v[j].w);
    const float rstd = 1.0f / sqrtf(wave_sum(s) * (1.f / D) + EPS);
    f32x4 o[8]; float mx = 0.f;
#pragma unroll
    for (int j = 0; j < 8; ++j) { o[j] = v[j] * rstd * gg[j]; mx = fmaxf(mx, fmaxf(fmaxf(fabsf(o[j].x), fabsf(o[j].y)), fmaxf(fabsf(o[j].z), fabsf(o[j].w)))); }
    mx = wave_max(mx); const float inv = mx > 0.f ? 127.0f / mx : 0.f;
    unsigned* o4 = (unsigned*)orow + lane;
#pragma unroll
    for (int j = 0; j < 8; ++j) o4[64 * j] = i8x4(o[j].x * inv, o[j].y * inv, o[j].z * inv, o[j].w * inv);
    if (lane == 0) *xsp = mx > 0.f ? mx * (1.0f / 127.0f) : 1.0f;
}
__device__ __forceinline__ void norm_phase_i8(const Ctx& c, const float* main, const float* g) {
    const int gw = c.bid * 8 + c.wave, NGW = c.G * 8;
    unsigned char* XN8 = c.ws + WS_XN; float* XS = (float*)(c.ws + WS_XS);
    f32x4 gg[8];
#pragma unroll
    for (int j = 0; j < 8; ++j) gg[j] = ((const f32x4*)g)[c.lane + 64 * j];
    f32x4 cur[8], nxt[8], nn[8];
    if (gw < MR) row_load_h(cur, c, gw, c.lane);
    if (gw + NGW < MR) row_load_h(nxt, c, gw + NGW, c.lane);
    for (int row = gw; row < MP; row += NGW) {
        const int nrow = row + 2 * NGW;
        if (nrow < MR) row_load_h(nn, c, nrow, c.lane);
        if (row < MR) rms_regs_i8g(cur, gg, XN8 + (size_t)row * D, XS + row, c.lane);
        else { v4u z = {0u, 0u, 0u, 0u}; v4u* o = (v4u*)(XN8 + (size_t)row * D); for (int j = 0; j < 2; ++j) o[c.lane + 64 * j] = z; if (c.lane == 0) XS[row] = 1.0f; }
#pragma unroll
        for (int j = 0; j < 8; ++j) { cur[j] = nxt[j]; nxt[j] = nn[j]; }
    }
}
__device__ __forceinline__ void rms_regs_f8(const f32x4 (&v)[8], const float* g, unsigned char* orow, int lane) {
    float s = 0.f;
#pragma unroll
    for (int j = 0; j < 8; ++j) s += (v[j].x * v[j].x + v[j].y * v[j].y) + (v[j].z * v[j].z + v[j].w * v[j].w);
    const float rstd = 1.0f / sqrtf(wave_sum(s) * (1.f / D) + EPS);
    unsigned* o4 = (unsigned*)orow + lane;
#pragma unroll
    for (int j = 0; j < 8; ++j) { const f32x4 gg = ((const f32x4*)g)[lane + 64 * j]; const f32x4 o = v[j] * rstd * gg; o4[64 * j] = f8x4(o.x, o.y, o.z, o.w); }
}
__device__ __forceinline__ void norm_phase_f8(const Ctx& c, const float* main, const float* g) {
    const int gw = c.bid * 8 + c.wave, NGW = c.G * 8;
    unsigned char* XN8 = c.ws + WS_XN;
    f32x4 cur[8], nxt[8];
    if (gw < MR) row_load(cur, h_row(c, main, gw), c.lane);
    for (int row = gw; row < MP; row += NGW) {
        const int nrow = row + NGW;
        if (nrow < MR) row_load(nxt, h_row(c, main, nrow), c.lane);
        if (row < MR) rms_regs_f8(cur, g, XN8 + (size_t)row * D, c.lane);
        else { v4u z = {0u, 0u, 0u, 0u}; v4u* o = (v4u*)(XN8 + (size_t)row * D); for (int j = 0; j < 2; ++j) o[c.lane + 64 * j] = z; }
#pragma unroll
        for (int j = 0; j < 8; ++j) cur[j] = nxt[j];
    }
}
__device__ __forceinline__ void norm_phase(const Ctx& c, const float* main, const float* g) {
    const int gw = c.bid * 8 + c.wave, NGW = c.G * 8;
    bf16* XN = (bf16*)(c.ws + WS_XN);
    f32x4 cur[8], nxt[8];
    if (gw < MR) row_load(cur, h_row(c, main, gw), c.lane);
    for (int row = gw; row < MP; row += NGW) {
        const int nrow = row + NGW;
        if (nrow < MR) row_load(nxt, h_row(c, main, nrow), c.lane);
        if (row < MR) rms_regs_bf16(cur, g, XN + (size_t)row * D, c.lane);
        else { v4u z = {0u, 0u, 0u, 0u}; v4u* o = (v4u*)(XN + (size_t)row * D); for (int j = 0; j < 4; ++j) o[c.lane + 64 * j] = z; }
#pragma unroll
        for (int j = 0; j < 8; ++j) cur[j] = nxt[j];
    }
}

__device__ __forceinline__ void ph_pre(const Ctx& c) {
    LAS float* scr = (LAS float*)(c.lds + c.wave * 16640);
    const int gw = c.bid * 8 + c.wave, NGW = c.G * 8;
    {
        int base = 0;
        for (int j = 0; j < 15; ++j) { if (j == 0 || j == 10 || j == 11 || j == 13) continue;
            const TJob t = job_l0(c, j); const int ni = t.nsg * (t.K / 64);
            int first = gw - (base % NGW); if (first < 0) first += NGW;
            for (int it = first; it < ni; it += NGW) run_job_item(t, it, scr, c.lane);
            base += ni; }
    }
    { float* hm = (float*)(c.ws + WS_HMPAD); const float* meta = c.in[I_META];
      for (int i = c.bid * 512 + c.tid; i < 256 * D; i += c.G * 512) hm[i] = i < NMETA * D ? meta[i] : 0.f; }
    { float* rt = (float*)(c.ws + WS_ROPE);
      for (int i = c.bid * 512 + c.tid; i < TT * 16; i += c.G * 512) { const int t = i >> 4, j = i & 15;
          const float fr = (float)exp(-(double)j * (1.0 / 16.0) * 13.122363377404328  );
          const float ang = (float)t * fr; const float cv = (float)cos((double)ang), sv = (float)sin((double)ang); rt[2 * i] = cv; rt[2 * i + 1] = sv;
          if ((j & 1) == 0) { float* r8 = rt + (size_t)TT * 32 + (size_t)t * 16 + (j >> 1) * 2; r8[0] = cv; r8[1] = sv; } } }
    { unsigned char* XN8 = c.ws + WS_XN; float* XS = (float*)(c.ws + WS_XS); const float* g = c.in[I_ABNORM]; const float* xin = c.in[I_X]; const float* meta = c.in[I_META];
      f32x4 gg[8];
#pragma unroll
      for (int j = 0; j < 8; ++j) gg[j] = ((const f32x4*)g)[c.lane + 64 * j];
      f32x4 cur[8], nxt[8], nn[8];
      if (gw < MR) row_load(cur, gw < MS ? xin + (size_t)gw * D : meta + (size_t)(gw - MS) * D, c.lane);
      if (gw + NGW < MR) row_load(nxt, gw + NGW < MS ? xin + (size_t)(gw + NGW) * D : meta + (size_t)(gw + NGW - MS) * D, c.lane);
      for (int row = gw; row < MP; row += NGW) {
          const int nrow = row + 2 * NGW;
          if (nrow < MR) row_load(nn, nrow < MS ? xin + (size_t)nrow * D : meta + (size_t)(nrow - MS) * D, c.lane);
          if (row < MR) rms_regs_i8g(cur, gg, XN8 + (size_t)row * D, XS + row, c.lane);
          else { v4u z = {0u, 0u, 0u, 0u}; v4u* o = (v4u*)(XN8 + (size_t)row * D); for (int j = 0; j < 2; ++j) o[c.lane + 64 * j] = z; if (c.lane == 0) XS[row] = 1.0f; }
#pragma unroll
          for (int j = 0; j < 8; ++j) { cur[j] = nxt[j]; nxt[j] = nn[j]; } } }
    ph_colmax(c);
}
__device__ __forceinline__ void ph_moecvt(const Ctx& c) {
    LAS float* scr = (LAS float*)(c.lds + c.wave * 18432);
    const int gw = c.bid * 8 + c.wave, NGW = c.G * 8;
    for (int it = gw; it < 24 * 3584; it += NGW) { const TJob t = job_moe(c, it / 3584); run_job_item(t, it % 3584, scr, c.lane); }
}

__device__ __forceinline__ void ph_conv(const Ctx& c) {
    const bf16* Z0 = (const bf16*)(c.ws + WS_Z0); bf16* XC = (bf16*)(c.ws + WS_XC);
    const float* cw = c.in[I_CONVW]; const float* cb = c.in[I_CONVB];
    const int c8 = ((c.bid * 512 + c.tid) & 127) * 8;
    float wk[4][8], bk[8];
#pragma unroll
    for (int k = 0; k < 8; ++k) { bk[k] = cb[c8 + k];
#pragma unroll
        for (int j = 0; j < 4; ++j) wk[j][k] = cw[j * 1024 + c8 + k]; }
    const int S = c.G * 512;
    for (int it0 = c.bid * 512 + c.tid; it0 < MP * 128; it0 += 4 * S) {
        v4u xv[4][4]; int rw[4];
#pragma unroll
        for (int q = 0; q < 4; ++q) { const int it = it0 + q * S; const int row = it >> 7; rw[q] = it < MP * 128 ? row : -1;
            int t = 0, b = 0; if (row < MS) { b = row >> 14; t = NMETA + (row & (SEQ - 1)); } else { b = 0; t = row - MS; }
#pragma unroll
            for (int j = 0; j < 4; ++j) { const int tp = t - 3 + j; xv[q][j] = (v4u){0u, 0u, 0u, 0u}; if (rw[q] >= 0 && row < MR && tp >= 0) xv[q][j] = *(const v4u*)(Z0 + (size_t)row_of(b, tp) * NABP + c8); } }
#pragma unroll
        for (int q = 0; q < 4; ++q) { const int row = rw[q];
            if (row >= 0) {
                float o[8];
                if (row >= MR) { for (int k = 0; k < 8; ++k) o[k] = 0.f; }
                else {
                    for (int k = 0; k < 8; ++k) o[k] = bk[k];
#pragma unroll
                    for (int j = 0; j < 4; ++j) { const unsigned xs[4] = {xv[q][j].x, xv[q][j].y, xv[q][j].z, xv[q][j].w};
#pragma unroll
                        for (int k = 0; k < 4; ++k) { o[2 * k] += wk[j][2 * k] * __builtin_bit_cast(float, xs[k] << 16); o[2 * k + 1] += wk[j][2 * k + 1] * __builtin_bit_cast(float, xs[k] & 0xffff0000u); } }
                }
                v4u w; w.x = pk2(o[0], o[1]); w.y = pk2(o[2], o[3]); w.z = pk2(o[4], o[5]); w.w = pk2(o[6], o[7]);
                *(v4u*)(XC + (size_t)row * 1024 + c8) = w; } }
    }
}
struct LruCh { float br, bi, sp; int colr; };
__device__ __forceinline__ void lru_step(const bf16* RI, const bf16* XC, const LruCh& k, int row, int ch, float& a, float& u) {
    const float rp = bf2f(RI[(size_t)row * D + k.colr]) + k.br, ip = bf2f(RI[(size_t)row * D + k.colr + 256]) + k.bi, xc = bf2f(XC[(size_t)row * 1024 + ch]);
    const float r = sigmoidf_(rp), ig = sigmoidf_(ip), la = -8.0f * r * k.sp;
    a = __expf(la); u = __builtin_amdgcn_sqrtf(fmaxf(1.0f - a * a, 0.f)) * ig * xc;
}
__device__ __forceinline__ LruCh lru_ch(const Ctx& c, int ch) {
    LruCh k; k.br = c.in[I_BR][ch]; k.bi = c.in[I_BI][ch]; const float lam = c.in[I_LAM][ch];
    k.sp = (lam > 0.f ? 0.f : -lam) + log1pf(expf(-fabsf(lam)));
    k.colr = (ch >> 8) * 512 + (ch & 255); return k;
}
__device__ __forceinline__ void ph_scan_a(const Ctx& c) {
    const bf16* RI = (const bf16*)(c.ws + WS_RI); const bf16* XC = (const bf16*)(c.ws + WS_XC);
    float* SA = (float*)(c.ws + WS_LSUM); float* SH = SA + 129 * 1024;
    for (int it = c.bid * 512 + c.tid; it < 129 * 1024; it += c.G * 512) {
        const int chunk = it >> 10, ch = it & 1023; const LruCh k = lru_ch(c, ch);
        const int r0 = chunk < 128 ? chunk * 256 : MS, nr = chunk < 128 ? 256 : NMETA;
        float h = 0.f, A = 1.f;
        for (int i0 = 0; i0 < nr; i0 += 16) { float a[16], u[16];
#pragma unroll
            for (int q = 0; q < 16; ++q) lru_step(RI, XC, k, r0 + i0 + q, ch, a[q], u[q]);
#pragma unroll
            for (int q = 0; q < 16; ++q) { h = a[q] * h + u[q]; A *= a[q]; } }
        SA[it] = A; SH[it] = h;
    }
}
__device__ __forceinline__ void ph_scan_c(const Ctx& c) {
    const bf16* RI = (const bf16*)(c.ws + WS_RI); const bf16* XC = (const bf16*)(c.ws + WS_XC); const bf16* Z0 = (const bf16*)(c.ws + WS_Z0);
    bf16* MIX = (bf16*)(c.ws + WS_MIX);
    const float* SA = (const float*)(c.ws + WS_LSUM); const float* SH = SA + 129 * 1024;
    for (int it = c.bid * 512 + c.tid; it < 129 * 1024; it += c.G * 512) {
        const int chunk = it >> 10, ch = it & 1023; const LruCh k = lru_ch(c, ch);
        const int r0 = chunk < 128 ? chunk * 256 : MS, nr = chunk < 128 ? 256 : NMETA;
        float h = 0.f;
        if (chunk < 128) { const int b = chunk >> 6, j = chunk & 63; h = SH[128 * 1024 + ch];
            for (int jj = 0; jj < j; jj += 16) { float sa[16], sh[16];
#pragma unroll
                for (int q = 0; q < 16; ++q) { const int j2 = jj + q < j ? jj + q : j - 1; const int cc = (b * 64 + j2) * 1024 + ch; sa[q] = SA[cc]; sh[q] = SH[cc]; }
#pragma unroll
                for (int q = 0; q < 16; ++q) if (jj + q < j) h = sa[q] * h + sh[q]; } }
        for (int i0 = 0; i0 < nr; i0 += 16) { float a[16], u[16], yb[16];
#pragma unroll
            for (int q = 0; q < 16; ++q) { lru_step(RI, XC, k, r0 + i0 + q, ch, a[q], u[q]); yb[q] = bf2f(Z0[(size_t)(r0 + i0 + q) * NABP + 1024 + ch]); }
#pragma unroll
            for (int q = 0; q < 16; ++q) { h = a[q] * h + u[q]; const float mv = h * gelu_tanh(yb[q]);
                if (G3_F8) ((unsigned char*)MIX)[(size_t)(r0 + i0 + q) * D + ch] = (unsigned char)f8x4(mv, 0.f, 0.f, 0.f); else MIX[(size_t)(r0 + i0 + q) * D + ch] = (bf16)f2bf(mv); } }
    }
}

struct GlaUnit { int row0, ntok, h, su; };
__device__ __forceinline__ GlaUnit gla_unit(int u) {
    GlaUnit g; if (u < 4) { g.row0 = MS; g.ntok = NMETA; g.h = u; g.su = -1; }
    else { const int v = u - 4, b = v >> 10, c1 = (v & 1023) >> 2; g.h = v & 3; g.row0 = b * SEQ + 64 * c1; g.ntok = 64; g.su = v; }
    return g;
}
__device__ __forceinline__ void ph_gla0(const Ctx& c) {
    const bf16* Z0 = (const bf16*)(c.ws + WS_Z0);
    bf16* QD = (bf16*)(c.ws + WS_QDG); bf16* KD = (bf16*)(c.ws + WS_KDG); bf16* KDT = (bf16*)(c.ws + WS_KDTG); bf16* VT = (bf16*)(c.ws + WS_VTG); float* DEC = (float*)(c.ws + WS_DEC);
    const float* wgk = c.in[I_WGK]; const float* bgk = c.in[I_BGK];
    const int gw = c.bid * 8 + c.wave, NGW = c.G * 8, lane = c.lane;
    for (int it = gw; it < GLA_UNITS * 6; it += NGW) {
        const int u = it / 6, slot = it - 6 * u; const GlaUnit g = gla_unit(u);
        if (slot < 2) {
            const int dk = 64 * slot + lane, col = g.h * 128 + dk;
            float w[16];
#pragma unroll
            for (int r = 0; r < 16; ++r) w[r] = wgk[r * 512 + col];
            const float bias = bgk[col];
            LAS float* gl = (LAS float*)(c.lds + c.wave * 4096);
            { v4u ga = (v4u){0u, 0u, 0u, 0u}, gb = ga;
              if (lane < g.ntok) { const bf16* zr = Z0 + (size_t)(g.row0 + lane) * NABP; ga = *(const v4u*)(zr + 5120); gb = *(const v4u*)(zr + 5128); }
              float f[16]; { float t0[8], t1[8]; unpack8(t0, ga); unpack8(t1, gb);
#pragma unroll
                  for (int r = 0; r < 8; ++r) { f[r] = t0[r]; f[8 + r] = t1[r]; } }
#pragma unroll
              for (int q4 = 0; q4 < 4; ++q4) *(LAS f32x4*)(gl + lane * 16 + 4 * q4) = (f32x4){f[4 * q4], f[4 * q4 + 1], f[4 * q4 + 2], f[4 * q4 + 3]}; }
            LDS_WAIT();
            float bc = 0.f;
            for (int t8 = 0; t8 < 64; t8 += 8) {
                unsigned pk[4];
                if (t8 < g.ntok) {
                    unsigned short qv[8], kv[8];
#pragma unroll
                    for (int i = 0; i < 8; ++i) { const bf16* zr = Z0 + (size_t)(g.row0 + t8 + i) * NABP; qv[i] = zr[2048 + col]; kv[i] = zr[2560 + col]; }
                    float kd[8];
#pragma unroll
                    for (int i = 0; i < 8; ++i) { float x = bias;
#pragma unroll
                        for (int q4 = 0; q4 < 4; ++q4) { const f32x4 gv = *(const LAS f32x4*)(gl + (t8 + i) * 16 + 4 * q4); x += gv.x * w[4 * q4] + gv.y * w[4 * q4 + 1] + gv.z * w[4 * q4 + 2] + gv.w * w[4 * q4 + 3]; }
                        bc += (fminf(x, 0.f) - __logf(1.0f + __expf(-fabsf(x)))) * (1.0f / 16.0f);
                        const size_t ro = (size_t)(g.row0 + t8 + i) * 512 + col;
                        QD[ro] = (bf16)f2bf(bf2f(qv[i]) * __expf(bc) * 0.08838834764831845f);
                        kd[i] = bf2f(kv[i]) * __expf(-bc); KD[ro] = (bf16)f2bf(kd[i]); }
#pragma unroll
                    for (int i = 0; i < 4; ++i) pk[i] = pk2(kd[2 * i], kd[2 * i + 1]);
                } else { pk[0] = pk[1] = pk[2] = pk[3] = 0u; }
                v4u o; o.x = pk[0]; o.y = pk[1]; o.z = pk[2]; o.w = pk[3];
                *(v4u*)(KDT + ((size_t)u * 128 + dk) * 64 + t8) = o;
            }
            LDS_WAIT();
            DEC[(size_t)u * 128 + dk] = __expf(bc);
        } else {
            const int dv = 64 * (slot - 2) + lane, col = 3072 + g.h * 256 + dv;
            for (int t8 = 0; t8 < 64; t8 += 8) {
                unsigned short vv[8];
#pragma unroll
                for (int i = 0; i < 8; ++i) vv[i] = (t8 < g.ntok) ? Z0[(size_t)(g.row0 + t8 + i) * NABP + col] : (unsigned short)0;
                v4u o; o.x = (unsigned)vv[0] | ((unsigned)vv[1] << 16); o.y = (unsigned)vv[2] | ((unsigned)vv[3] << 16); o.z = (unsigned)vv[4] | ((unsigned)vv[5] << 16); o.w = (unsigned)vv[6] | ((unsigned)vv[7] << 16);
                *(v4u*)(VT + ((size_t)u * 256 + dv) * 64 + t8) = o;
            }
        }
    }
}
__device__ __forceinline__ void ph_gla1(const Ctx& c) {
    const bf16* KDT = (const bf16*)(c.ws + WS_KDTG); const bf16* VT = (const bf16*)(c.ws + WS_VTG); bf16* DST = (bf16*)(c.ws + WS_DST);
    const int lane = c.lane, g4 = lane >> 4, l15 = lane & 15;
    const int gw = c.bid * 8 + c.wave, NGW = c.G * 8;
    for (int it = gw; it < GLA_UNITS * 8; it += NGW) {
        const int u = it >> 3, w = it & 7;
        bf16x8 af[2][2], bfr[8][2];
#pragma unroll
        for (int ks = 0; ks < 2; ++ks) {
#pragma unroll
            for (int a = 0; a < 2; ++a) af[a][ks] = *(const bf16x8*)(VT + ((size_t)u * 256 + (2 * w + a) * 16 + l15) * 64 + ks * 32 + 8 * g4);
#pragma unroll
            for (int b = 0; b < 8; ++b) bfr[b][ks] = *(const bf16x8*)(KDT + ((size_t)u * 128 + b * 16 + l15) * 64 + ks * 32 + 8 * g4); }
        f32x4 acc[2][8];
#pragma unroll
        for (int a = 0; a < 2; ++a)
#pragma unroll
            for (int b = 0; b < 8; ++b) { acc[a][b] = (f32x4){0.f, 0.f, 0.f, 0.f};
#pragma unroll
                for (int ks = 0; ks < 2; ++ks) acc[a][b] = __builtin_amdgcn_mfma_f32_16x16x32_bf16(bfr[b][ks], af[a][ks], acc[a][b], 0, 0, 0); }
        bf16* dst = DST + (size_t)u * 32768;
#pragma unroll
        for (int a = 0; a < 2; ++a)
#pragma unroll
            for (int b = 0; b < 8; ++b) { v2u o; o.x = pk2(acc[a][b][0], acc[a][b][1]); o.y = pk2(acc[a][b][2], acc[a][b][3]);
                *(v2u*)(dst + ((2 * w + a) * 16 + l15) * 128 + b * 16 + 4 * g4) = o; }
    }
}
__device__ __forceinline__ void ph_gla2(const Ctx& c) {
    const bf16* DST = (const bf16*)(c.ws + WS_DST); const float* DEC = (const float*)(c.ws + WS_DEC); bf16* ST = (bf16*)(c.ws + WS_ST);
    const int gw = c.bid * 8 + c.wave, NGW = c.G * 8;
    for (int it = gw; it < 2048; it += NGW) {
        const int b = it >> 10, h = (it >> 8) & 3, dv = it & 255;
        const unsigned s0 = *(const unsigned*)(DST + (size_t)h * 32768 + dv * 128 + 2 * c.lane);
        f32x2 S = (f32x2){__builtin_bit_cast(float, s0 << 16), __builtin_bit_cast(float, s0 & 0xffff0000u)} * *(const f32x2*)(DEC + (size_t)h * 128 + 2 * c.lane);
        for (int c0 = 0; c0 < 256; c0 += 16) {
            unsigned dsb[16]; f32x2 de[16];
#pragma unroll
            for (int k = 0; k < 16; ++k) { const size_t u = 4 + (size_t)b * 1024 + (size_t)(c0 + k) * 4 + h;
                dsb[k] = *(const unsigned*)(DST + u * 32768 + dv * 128 + 2 * c.lane); de[k] = *(const f32x2*)(DEC + u * 128 + 2 * c.lane); }
#pragma unroll
            for (int k = 0; k < 16; ++k) { const size_t su = (size_t)b * 1024 + (size_t)(c0 + k) * 4 + h;
                *(unsigned*)(ST + su * 32768 + dv * 128 + 2 * c.lane) = pk2(S.x, S.y);
                S = de[k] * (S + (f32x2){__builtin_bit_cast(float, dsb[k] << 16), __builtin_bit_cast(float, dsb[k] & 0xffff0000u)}); }
        }
    }
}
constexpr int GL_ATT = 0, GL_SSQ = 9216, GL_RST = 9216 + 2048;
__device__ __forceinline__ void ph_gla3(const Ctx& c) {
    const bf16* Z0 = (const bf16*)(c.ws + WS_Z0); const bf16* ST = (const bf16*)(c.ws + WS_ST); bf16* MIX = (bf16*)(c.ws + WS_MIX);
    const bf16* QD = (const bf16*)(c.ws + WS_QDG); const bf16* KD = (const bf16*)(c.ws + WS_KDG); const bf16* VT = (const bf16*)(c.ws + WS_VTG);
    LAS bf16* att = (LAS bf16*)(c.lds + GL_ATT); LAS float* ssq = (LAS float*)(c.lds + GL_SSQ); LAS float* rst = (LAS float*)(c.lds + GL_RST);
    const int lane = c.lane, g4 = lane >> 4, l15 = lane & 15, w = c.wave;
    const float* gnorm = c.in[I_GLANORM];
    for (int u = c.bid; u < GLA_UNITS; u += c.G) {
        const GlaUnit g = gla_unit(u);
        const bf16* qd = QD + (size_t)g.row0 * 512 + g.h * 128; const bf16* kd = KD + (size_t)g.row0 * 512 + g.h * 128;
        {
            const int ti = w >> 1;
            bf16x8 af[4];
#pragma unroll
            for (int ks = 0; ks < 4; ++ks) af[ks] = *(const bf16x8*)(qd + (size_t)(ti * 16 + l15) * 512 + ks * 32 + 8 * g4);
#pragma unroll
            for (int q = 0; q < 2; ++q) { const int sj = 2 * (w & 1) + q; f32x4 a = (f32x4){0.f, 0.f, 0.f, 0.f};
                if (sj <= ti) {
                    bf16x8 bfr[4];
#pragma unroll
                    for (int ks = 0; ks < 4; ++ks) bfr[ks] = *(const bf16x8*)(kd + (size_t)(sj * 16 + l15) * 512 + ks * 32 + 8 * g4);
#pragma unroll
                    for (int ks = 0; ks < 4; ++ks) a = __builtin_amdgcn_mfma_f32_16x16x32_bf16(af[ks], bfr[ks], a, 0, 0, 0); }
#pragma unroll
                for (int j = 0; j < 4; ++j) { const int t = ti * 16 + 4 * g4 + j, s2 = sj * 16 + l15; att[t * 72 + s2] = (bf16)f2bf((s2 <= t && t < g.ntok) ? a[j] : 0.f); } }
        }
        __syncthreads();
        f32x4 acc[4][2];
#pragma unroll
        for (int ti = 0; ti < 4; ++ti)
#pragma unroll
            for (int n = 0; n < 2; ++n) acc[ti][n] = (f32x4){0.f, 0.f, 0.f, 0.f};
        if (g.su >= 0) {
            const bf16* st = ST + (size_t)g.su * 32768;
#pragma unroll
            for (int ks = 0; ks < 4; ++ks) { bf16x8 bfr[2], afr[4];
#pragma unroll
                for (int n = 0; n < 2; ++n) bfr[n] = *(const bf16x8*)(st + (size_t)(32 * w + 16 * n + l15) * 128 + ks * 32 + 8 * g4);
#pragma unroll
                for (int ti = 0; ti < 4; ++ti) afr[ti] = *(const bf16x8*)(qd + (size_t)(ti * 16 + l15) * 512 + ks * 32 + 8 * g4);
#pragma unroll
                for (int ti = 0; ti < 4; ++ti)
#pragma unroll
                    for (int n = 0; n < 2; ++n) acc[ti][n] = __builtin_amdgcn_mfma_f32_16x16x32_bf16(afr[ti], bfr[n], acc[ti][n], 0, 0, 0); }
        }
#pragma unroll
        for (int ks = 0; ks < 2; ++ks) { bf16x8 bfr[2];
#pragma unroll
            for (int n = 0; n < 2; ++n) bfr[n] = *(const bf16x8*)(VT + ((size_t)u * 256 + 32 * w + 16 * n + l15) * 64 + ks * 32 + 8 * g4);
#pragma unroll
            for (int ti = 0; ti < 4; ++ti) { const bf16x8 af = *(const LAS bf16x8*)(att + (ti * 16 + l15) * 72 + ks * 32 + 8 * g4);
#pragma unroll
                for (int n = 0; n < 2; ++n) acc[ti][n] = __builtin_amdgcn_mfma_f32_16x16x32_bf16(af, bfr[n], acc[ti][n], 0, 0, 0); } }
        LAS float* OT = (LAS float*)(c.lds + 16384);
#pragma unroll
        for (int ti = 0; ti < 4; ++ti)
#pragma unroll
            for (int j = 0; j < 4; ++j) { float p = acc[ti][0][j] * acc[ti][0][j] + acc[ti][1][j] * acc[ti][1][j];
                p = row_sum16(p);
                if (l15 == 0) ssq[w * 64 + ti * 16 + 4 * g4 + j] = p;
#pragma unroll
                for (int n = 0; n < 2; ++n) OT[(ti * 16 + 4 * g4 + j) * 260 + 32 * w + 16 * n + l15] = acc[ti][n][j]; }
        __syncthreads();
        if (c.tid < 64) { float s2 = 0.f; for (int k = 0; k < 8; ++k) s2 += ssq[k * 64 + c.tid]; rst[c.tid] = 1.0f / sqrtf(s2 * (1.f / 256.f) + EPS); }
        __syncthreads();
        { const int e0 = (c.tid & 31) * 8; const f32x4 gn0 = *(const f32x4*)(gnorm + e0), gn1 = *(const f32x4*)(gnorm + e0 + 4);
#pragma unroll
          for (int k = 0; k < 4; ++k) { const int t = (c.tid >> 5) + 16 * k;
              if (t < g.ntok) { const float rs = rst[t]; const size_t row = (size_t)(g.row0 + t);
                  const f32x4 o0 = *(const LAS f32x4*)(OT + t * 260 + e0), o1 = *(const LAS f32x4*)(OT + t * 260 + e0 + 4);
                  const v4u gv = *(const v4u*)(Z0 + row * NABP + 4096 + g.h * 256 + e0); const unsigned gs[4] = {gv.x, gv.y, gv.z, gv.w};
                  float y[8];
#pragma unroll
                  for (int q = 0; q < 4; ++q) { const float ga = __builtin_bit_cast(float, gs[q] << 16), gb = __builtin_bit_cast(float, gs[q] & 0xffff0000u);
                      const float oa = q < 2 ? o0[2 * q] : o1[2 * q - 4], ob = q < 2 ? o0[2 * q + 1] : o1[2 * q - 3];
                      const float na = q < 2 ? gn0[2 * q] : gn1[2 * q - 4], nb = q < 2 ? gn0[2 * q + 1] : gn1[2 * q - 3];
                      y[2 * q] = oa * rs * na * siluf_(ga); y[2 * q + 1] = ob * rs * nb * siluf_(gb); }
                  if (G3_F8) { v2u wv; wv.x = f8x4(y[0], y[1], y[2], y[3]); wv.y = f8x4(y[4], y[5], y[6], y[7]); *(v2u*)((unsigned char*)MIX + row * D + 1024 + g.h * 256 + e0) = wv; }
                  else { v4u wv; wv.x = pk2(y[0], y[1]); wv.y = pk2(y[2], y[3]); wv.z = pk2(y[4], y[5]); wv.w = pk2(y[6], y[7]);
                  *(v4u*)(MIX + row * D + 1024 + g.h * 256 + e0) = wv; } } } }
        __syncthreads();
    }
}

__device__ __forceinline__ void rope_chunk(float (&o)[8], const v4u own, const v4u par, const f32x4 (&cs)[4], float sgn) {
    const unsigned a[4] = {own.x, own.y, own.z, own.w}, p[4] = {par.x, par.y, par.z, par.w};
#pragma unroll
    for (int k = 0; k < 4; ++k) { const float a0 = __builtin_bit_cast(float, a[k] << 16), a1 = __builtin_bit_cast(float, a[k] & 0xffff0000u), p0 = __builtin_bit_cast(float, p[k] << 16), p1 = __builtin_bit_cast(float, p[k] & 0xffff0000u);
        o[2 * k] = a0 * cs[k].x + sgn * p0 * cs[k].y; o[2 * k + 1] = a1 * cs[k].z + sgn * p1 * cs[k].w; }
}
__device__ __forceinline__ v2u fp8x8(const float (&o)[8]) {
    unsigned w0 = 0u, w1 = 0u;
    w0 = __builtin_amdgcn_cvt_pk_fp8_f32(o[0], o[1], w0, false); w0 = __builtin_amdgcn_cvt_pk_fp8_f32(o[2], o[3], w0, true);
    w1 = __builtin_amdgcn_cvt_pk_fp8_f32(o[4], o[5], w1, false); w1 = __builtin_amdgcn_cvt_pk_fp8_f32(o[6], o[7], w1, true);
    v2u w; w.x = w0; w.y = w1; return w;
}
__device__ __forceinline__ v4u bf16x8_pack(const float (&o)[8]) { v4u w; w.x = pk2(o[0], o[1]); w.y = pk2(o[2], o[3]); w.z = pk2(o[4], o[5]); w.w = pk2(o[6], o[7]); return w; }
__device__ __forceinline__ void ph_rope(const Ctx& c) {
    bf16* Z1 = (bf16*)(c.ws + WS_Z1); bf16* KIP = (bf16*)(c.ws + WS_KIP); float* WIS = (float*)(c.ws + WS_WIS); const float* rt = (const float*)(c.ws + WS_ROPE); const float* rt8 = rt + (size_t)TT * 32;
    const int gw = c.bid * 8 + c.wave, NGW = c.G * 8, lane = c.lane;
    const int q_own = (lane >> 2) * 128 + 8 * (lane & 3), q_par = (lane >> 2) * 128 + 8 * ((lane & 3) ^ 2);
    const int k_own = 2048 + 8 * lane, k_par = 2048 + 8 * (lane ^ 2);
    const bool k_rot = (lane & 15) < 4;
    const int il = lane < 24 ? lane : 23;
    const int i_own = il < 16 ? 3072 + (il >> 1) * 64 + 8 * (il & 1) : 3584 + 8 * (il - 16);
    const int i_par = il < 16 ? 3072 + (il >> 1) * 64 + 8 * ((il & 1) ^ 1) : 3584 + 8 * ((il - 16) < 2 ? ((il - 16) ^ 1) : (il - 16));
    const bool i_rot = il < 16 || (il - 16) < 2; const float i_sgn = (il < 16 ? (il & 1) : ((il - 16) & 1)) ? 1.f : -1.f;
    const float qk_sgn = (lane & 2) ? 1.f : -1.f;
#pragma unroll 2
    for (int row = gw; row < MR; row += NGW) {
        const int t = row < MS ? NMETA + (row & (SEQ - 1)) : row - MS;
        bf16* z = Z1 + (size_t)row * NCP;
        const v4u qo = *(const v4u*)(z + q_own), qp = *(const v4u*)(z + q_par), ko = *(const v4u*)(z + k_own), kp = *(const v4u*)(z + k_par), vo = *(const v4u*)(z + 2560 + 8 * lane);
        const v4u io = *(const v4u*)(z + i_own), ip = *(const v4u*)(z + i_par);
        const float wv = bf2f(z[3648 + (lane & 7)]);
        f32x4 cs[4], cs8[4]; const f32x4* tp = (const f32x4*)(rt + (size_t)t * 32 + 16 * (lane & 1)); const f32x4* tp8 = (const f32x4*)(rt8 + (size_t)t * 16);
#pragma unroll
        for (int k = 0; k < 4; ++k) { cs[k] = tp[k]; cs8[k] = tp8[k]; }
        float o[8];
        rope_chunk(o, qo, qp, cs, qk_sgn); *(v4u*)(z + q_own) = bf16x8_pack(o);
        if (k_rot) rope_chunk(o, ko, kp, cs, qk_sgn); else unpack8(o, ko);
        *(v2u*)(c.ws + WS_K8 + (size_t)row * 512 + 8 * lane) = fp8x8(o);
        unpack8(o, vo); *(v2u*)(c.ws + WS_V8 + (size_t)row * 512 + 8 * lane) = fp8x8(o);
        v4u iv = io;
        if (i_rot) { rope_chunk(o, io, ip, cs8, i_sgn); iv = bf16x8_pack(o); }
        if (lane < 16) *(v4u*)(z + i_own) = iv;
        else if (lane < 24) { const int ch = lane - 16;
            if (row < MS) *(v4u*)(KIP + (size_t)(row >> 14) * KIP_STRIDE * 64 + kip_off(t, ch)) = iv;
            else { *(v4u*)(KIP + kip_off(t, ch)) = iv; *(v4u*)(KIP + (size_t)KIP_STRIDE * 64 + kip_off(t, ch)) = iv; } }
        else if (lane < 32) WIS[(size_t)row * 8 + (lane - 24)] = wv;
    }
}
constexpr int IX_CAP = 576, IX_KEEP = 240, IX_TRIG = IX_CAP - 64;
__device__ __forceinline__ float relu_(float x) { const int i = __builtin_bit_cast(int, x); return __builtin_bit_cast(float, i > 0 ? i : 0); }
typedef short s2_t __attribute__((ext_vector_type(2)));
constexpr float IX_QS = 1.0f / 512.0f, IX_WS = 1024.0f;
__device__ __forceinline__ unsigned ix_pack(int s, int key) {
    const int k = s < -(1 << 27) ? -(1 << 27) : (s > (1 << 27) - 1 ? (1 << 27) - 1 : s);
    return (((unsigned)(k + (1 << 27)) << 4) & 0xFFFF8000u) | (unsigned)(32767 - key);
}
__device__ __forceinline__ int ix_thr(unsigned v) { return (int)((v >> 15) << 11) - (1 << 27); }
__device__ __forceinline__ unsigned wave_or_u32(unsigned x) {
    x |= (unsigned)__builtin_amdgcn_update_dpp(0, (int)x, 0xB1, 0xf, 0xf, true); x |= (unsigned)__builtin_amdgcn_update_dpp(0, (int)x, 0x4E, 0xf, 0xf, true);
    x |= (unsigned)__builtin_amdgcn_update_dpp(0, (int)x, 0x124, 0xf, 0xf, true); x |= (unsigned)__builtin_amdgcn_update_dpp(0, (int)x, 0x128, 0xf, 0xf, true);
    return (unsigned)__builtin_amdgcn_readlane((int)x, 0) | (unsigned)__builtin_amdgcn_readlane((int)x, 16) | (unsigned)__builtin_amdgcn_readlane((int)x, 32) | (unsigned)__builtin_amdgcn_readlane((int)x, 48);
}
template <bool EXACT>
__device__ __forceinline__ void ix_compact(LAS unsigned* buf, LAS unsigned* cnt, LAS int* tau, int q, int lane, int nmin) {
    LDS_WAIT();
    const int n = (int)cnt[q];
    if (n < nmin) return;
    const int tprev = tau[q];
    unsigned e[9];
#pragma unroll
    for (int i = 0; i < 9; ++i) e[i] = (lane + 64 * i < n) ? buf[q * IX_CAP + lane + 64 * i] : 0u;
    const unsigned orv = wave_or_u32(e[0] | e[1] | e[2] | e[3] | e[4] | e[5] | e[6] | e[7] | e[8]);
    const unsigned vprev = tprev == (int)0x80000000 ? 0u : (((unsigned)(tprev + (1 << 27)) >> 11) << 15);
    const unsigned diff = vprev ^ orv;
    const int top = diff ? 31 - __builtin_clz(diff) : -1;
    unsigned v = top >= 31 ? 0u : (top < 0 ? vprev : (vprev & ~((2u << top) - 1u)));
    int kept = n;
    int lowbit = (EXACT || top < 15) ? 0 : 15;
    for (int bit = top; bit >= lowbit; --bit) { const unsigned cand = v | (1u << bit); int cc = 0;
#pragma unroll
        for (int i = 0; i < 9; ++i) cc += __builtin_popcountll(__ballot(e[i] >= cand));
        if (cc >= IX_KEEP) { v = cand; kept = cc; }
        if (EXACT ? kept == IX_KEEP : kept <= IX_KEEP + 40) break;
        if (!EXACT && bit == 15) lowbit = 0;
    }
    int base = 0;
#pragma unroll
    for (int i = 0; i < 9; ++i) { const bool keep = e[i] >= v; const unsigned long long m = __ballot(keep);
        const int pos = base + (int)__builtin_amdgcn_mbcnt_hi((unsigned)(m >> 32), __builtin_amdgcn_mbcnt_lo((unsigned)m, 0u));
        if (keep) buf[q * IX_CAP + pos] = e[i]; base += __builtin_popcountll(m); }
    if (lane == 0) { cnt[q] = (unsigned)base; tau[q] = ix_thr(v); }
    LDS_WAIT();
}
__device__ __forceinline__ void ix_task(const Ctx& c, int b, int grp) {
    const bf16* Z1 = (const bf16*)(c.ws + WS_Z1); const bf16* KIP = (const bf16*)(c.ws + WS_KIP) + (size_t)b * KIP_STRIDE * 64; const float* WIS = (const float*)(c.ws + WS_WIS);
    unsigned short* SEL = (unsigned short*)(c.ws + WS_SEL); int* SELCNT = (int*)(c.ws + WS_SELCNT);
    LAS unsigned* buf = (LAS unsigned*)c.lds; LAS unsigned* cnt = (LAS unsigned*)(c.lds + 64 * IX_CAP * 4); LAS int* tau = (LAS int*)(c.lds + 64 * IX_CAP * 4 + 256);
    const int lane = c.lane, g4 = lane >> 4, l15 = lane & 15, qs = c.wave * 8;
    const int t0 = NMETA + 8 * grp;
    const int qrow0 = b * SEQ + 8 * grp;
    if (lane < 8) { cnt[qs + lane] = 0u; tau[qs + lane] = (int)0x80000000; }
    bf16x8 af[2][2][2]; s2_t wq[2][4];
#pragma unroll
    for (int qg = 0; qg < 2; ++qg) { const size_t ro = (size_t)(qrow0 + 4 * qg + (l15 >> 2)) * NCP + 3072;
#pragma unroll
        for (int hh = 0; hh < 2; ++hh)
#pragma unroll
            for (int ks = 0; ks < 2; ++ks) af[qg][hh][ks] = *(const bf16x8*)(Z1 + ro + (4 * hh + (l15 & 3)) * 64 + 32 * ks + 8 * g4);
        const float* wp = WIS + (size_t)(qrow0 + 4 * qg + g4) * 8;
#pragma unroll
        for (int h = 0; h < 4; ++h) wq[qg][h] = __builtin_bit_cast(s2_t, __builtin_amdgcn_cvt_pk_i16((int)rintf(wp[2 * h] * IX_WS), (int)rintf(wp[2 * h + 1] * IX_WS))); }
#pragma unroll
    for (int qg = 0; qg < 2; ++qg)
#pragma unroll
        for (int hh = 0; hh < 2; ++hh)
#pragma unroll
            for (int ks = 0; ks < 2; ++ks) { const v4u u = __builtin_bit_cast(v4u, af[qg][hh][ks]); const unsigned uu[4] = {u.x, u.y, u.z, u.w}; unsigned r[4];
#pragma unroll
                for (int q = 0; q < 4; ++q) r[q] = pk2(__builtin_bit_cast(float, uu[q] << 16) * IX_QS, __builtin_bit_cast(float, uu[q] & 0xffff0000u) * IX_QS);
                v4u o; o.x = r[0]; o.y = r[1]; o.z = r[2]; o.w = r[3]; af[qg][hh][ks] = __builtin_bit_cast(bf16x8, o); }
    int th[2] = {(int)0x80000000, (int)0x80000000};
    int cq[2] = {0, 0};
    const unsigned ltmask = (1u << l15) - 1u;
    const int qb0 = (qs + g4) * IX_CAP, qb1 = (qs + 4 + g4) * IX_CAP;
    LDS_WAIT();
#ifdef IX_PROBE_TWICE
    for (int rep_ = 0; rep_ < 2; ++rep_) { th[0] = th[1] = rep_ == 0 ? 0x7fffffff : (int)0x80000000;
#endif
    bf16x8 kr0[4][2], kr1[4][2];
    const int NI = (t0 + 7 - NMETA) / 128 + 1, NU = t0 >= 143 ? (t0 - 143) / 128 + 1 : 0;
    const int rot = NU > 0 ? (int)(((unsigned)(c.bid >> 3) * (unsigned)NU) >> 5) : 0;
    int kb0 = NMETA + 128 * (NU > 0 ? rot : 0);
    asm volatile("" :: "v"(af[0][0][0]), "v"(af[0][0][1]), "v"(af[0][1][0]), "v"(af[0][1][1]), "v"(af[1][0][0]), "v"(af[1][0][1]), "v"(af[1][1][0]), "v"(af[1][1][1]));
    asm volatile("" :: "v"(wq[0][0]), "v"(wq[0][1]), "v"(wq[0][2]), "v"(wq[0][3]), "v"(wq[1][0]), "v"(wq[1][1]), "v"(wq[1][2]), "v"(wq[1][3]));
#pragma unroll
    for (int tl = 0; tl < 4; ++tl) {
#pragma unroll
        for (int ks = 0; ks < 2; ++ks) kr0[tl][ks] = *(const bf16x8*)(KIP + ((size_t)((kb0 >> 4) + tl) * 128 + 64 * ks + lane) * 8);
        asm volatile("" ::: "memory"); }
#pragma unroll
    for (int tl = 0; tl < 4; ++tl) {
#pragma unroll
        for (int ks = 0; ks < 2; ++ks) kr1[tl][ks] = *(const bf16x8*)(KIP + ((size_t)((kb0 >> 4) + 4 + tl) * 128 + 64 * ks + lane) * 8);
        asm volatile("" ::: "memory"); }
    const int klim0 = t0 + g4, klim1 = t0 + 4 + g4;
    const int ixdummy = 64 * IX_CAP + 128 + lane;
#define IX_BLOCK(CB, KB0, KBN, MASKED) { \
        _Pragma("unroll") \
        for (int tl = 0; tl < 4; ++tl) { \
            const int key = (KB0) + 16 * tl + l15; \
            f32x4 dd[2][2]; \
            _Pragma("unroll") \
            for (int qg = 0; qg < 2; ++qg) { dd[qg][0] = (f32x4){0.f, 0.f, 0.f, 0.f}; dd[qg][1] = dd[qg][0]; \
                _Pragma("unroll") \
                for (int ks = 0; ks < 2; ++ks) { dd[qg][0] = __builtin_amdgcn_mfma_f32_16x16x32_bf16(af[qg][0][ks], CB[tl][ks], dd[qg][0], 0, 0, 0); dd[qg][1] = __builtin_amdgcn_mfma_f32_16x16x32_bf16(af[qg][1][ks], CB[tl][ks], dd[qg][1], 0, 0, 0); } } \
            _Pragma("unroll") \
            for (int ks = 0; ks < 2; ++ks) CB[tl][ks] = *(const bf16x8*)(KIP + ((size_t)(((KBN) >> 4) + tl) * 128 + 64 * ks + lane) * 8); \
            if (IX_LIGHT) { asm volatile("" :: "v"(dd[0][0]), "v"(dd[0][1]), "v"(dd[1][0]), "v"(dd[1][1])); } else \
            _Pragma("unroll") \
            for (int qg = 0; qg < 2; ++qg) { const f32x4 d0 = dd[qg][0], d1 = dd[qg][1]; \
                int sv = 0;        \
                sv = __builtin_amdgcn_sdot2(__builtin_bit_cast(s2_t, __builtin_amdgcn_cvt_pknorm_u16(d0[0], d0[1])), wq[qg][0], sv, false); \
                sv = __builtin_amdgcn_sdot2(__builtin_bit_cast(s2_t, __builtin_amdgcn_cvt_pknorm_u16(d0[2], d0[3])), wq[qg][1], sv, false); \
                sv = __builtin_amdgcn_sdot2(__builtin_bit_cast(s2_t, __builtin_amdgcn_cvt_pknorm_u16(d1[0], d1[1])), wq[qg][2], sv, false); \
                sv = __builtin_amdgcn_sdot2(__builtin_bit_cast(s2_t, __builtin_amdgcn_cvt_pknorm_u16(d1[2], d1[3])), wq[qg][3], sv, false); \
                  \
                  \
                const bool ps = MASKED ? ((sv > th[qg]) & (key <= (qg ? klim1 : klim0))) : (sv > th[qg]); \
                const unsigned long long m = __builtin_amdgcn_ballot_w64(ps); \
                const unsigned half = g4 >= 2 ? (unsigned)(m >> 32) : (unsigned)m; \
                const unsigned field = (half >> (16 * (g4 & 1))) & 0xFFFFu; \
                const int pos = cq[qg] + __builtin_popcount(field & ltmask); \
                buf[ps ? (qg ? qb1 : qb0) + pos : ixdummy] = ix_pack(sv, key); \
                cq[qg] += __builtin_popcount(field); \
            } \
        } \
        if (__any(cq[0] >= IX_TRIG || cq[1] >= IX_TRIG)) { \
            if (l15 == 0) { cnt[qs + g4] = (unsigned)cq[0]; cnt[qs + 4 + g4] = (unsigned)cq[1]; } \
            LDS_WAIT(); \
            for (int i = 0; i < 8; ++i) ix_compact<false>(buf, cnt, tau, qs + i, lane, IX_TRIG); \
            LDS_WAIT(); \
            th[0] = tau[qs + g4]; th[1] = tau[qs + 4 + g4]; cq[0] = (int)cnt[qs + g4]; cq[1] = (int)cnt[qs + 4 + g4]; \
        } }
    int it = 0;
#ifdef IX_PROBE_LIGHT
#define IX_LIGHT 1
    if (rep_ == 0) {
#pragma unroll 1
    for (; it < NI; ++it) {
        const int kbn = NMETA + 128 * (it + 1);
        IX_BLOCK(kr0, kb0, kbn, false)
        IX_BLOCK(kr1, kb0 + 64, kbn + 64, false)
        kb0 = kbn;
    } }
#undef IX_LIGHT
#endif
#define IX_LIGHT 0
#pragma unroll 1
    for (; it < NU; ++it) {
        int nx = it + 1 + rot; nx = nx >= NU ? nx - NU : nx; if (it + 1 >= NU) nx = it + 1;
#ifdef IX_PROBE_SAMEBLOCK
        const int kbn = rep_ == 0 ? NMETA : NMETA + 128 * nx;
#else
        const int kbn = NMETA + 128 * nx;
#endif
        IX_BLOCK(kr0, kb0, kbn, false)
        IX_BLOCK(kr1, kb0 + 64, kbn + 64, false)
        kb0 = kbn;
    }
#pragma unroll 1
    for (; it < NI; ++it) {
        const int kbn = kb0 + 128;
        IX_BLOCK(kr0, kb0, kbn, true)
        IX_BLOCK(kr1, kb0 + 64, kbn + 64, true)
        kb0 = kbn;
    }
#undef IX_BLOCK
#undef IX_LIGHT
    if (l15 == 0) { cnt[qs + g4] = (unsigned)cq[0]; cnt[qs + 4 + g4] = (unsigned)cq[1]; }
    LDS_WAIT();
#ifdef IX_PROBE_TWICE
    }
#endif
    for (int i = 0; i < 8; ++i) {
        ix_compact<true>(buf, cnt, tau, qs + i, lane, IX_KEEP + 1);
        LDS_WAIT();
        const int n = (int)cnt[qs + i];
        for (int j = lane; j < n; j += 64) SEL[(size_t)(qrow0 + i) * IX_KEEP + j] = (unsigned short)(32767u - (buf[(qs + i) * IX_CAP + j] & 0x7FFFu));
        if (lane == 0) SELCNT[qrow0 + i] = n;
    }
    LDS_WAIT();
}
__device__ __forceinline__ void ph_index(const Ctx& c) {
    const int gw = c.bid * 8 + c.wave, NGW = c.G * 8;
    for (int p = gw; p < 2048; p += NGW) { ix_task(c, 0, 2047 - p); ix_task(c, 1, p); }
}
__device__ __forceinline__ unsigned pk_fp8x4(unsigned lo2, unsigned hi2) {
    unsigned w = 0u;
    w = __builtin_amdgcn_cvt_pk_fp8_f32(__builtin_bit_cast(float, lo2 << 16), __builtin_bit_cast(float, lo2 & 0xffff0000u), w, false);
    w = __builtin_amdgcn_cvt_pk_fp8_f32(__builtin_bit_cast(float, hi2 << 16), __builtin_bit_cast(float, hi2 & 0xffff0000u), w, true);
    return w;
}
__device__ __forceinline__ void ph_attn(const Ctx& c) {
    const bf16* Z1 = (const bf16*)(c.ws + WS_Z1); const unsigned short* SEL = (const unsigned short*)(c.ws + WS_SEL); const int* SELCNT = (const int*)(c.ws + WS_SELCNT);
    bf16* ATT = (bf16*)(c.ws + WS_ATT); const unsigned char* K8 = c.ws + WS_K8; const unsigned char* V8 = c.ws + WS_V8;
    LAS int* rows = (LAS int*)(c.lds + c.wave * 14336); LAS float* P = (LAS float*)(c.lds + c.wave * 14336 + 1024);
    LAS unsigned char* Vs = c.lds + c.wave * 14336 + 5120;
    LAS unsigned char* P8 = (LAS unsigned char*)P;
    const int lane = c.lane, g4 = lane >> 4, l15 = lane & 15, rsub = lane >> 3, dseg = lane & 7;
    const int cls = c.bid & 7, b = cls >> 2, g = cls & 3;
    const int rank = (c.bid >> 3) * 8 + c.wave, nrank = (c.G >> 3) * 8;
    for (int t = rank; t < TT; t += nrank) {
        if (b == 1 && t < NMETA) continue;
        const int qrow = row_of(b, t);
        const bf16* qp0 = Z1 + (size_t)qrow * NCP + (4 * g + (l15 < 4 ? l15 : 0)) * 128 + 16 * g4;
        const v4u xa = *(const v4u*)qp0, xb = *(const v4u*)(qp0 + 8), xc = *(const v4u*)(qp0 + 64), xd = *(const v4u*)(qp0 + 72);
        int n;
        if (t < NMETA) { n = t + 1; for (int j = lane; j < 256; j += 64) rows[j] = MS + (j < n ? j : 0); }
        else {
            int sj[4];
#pragma unroll
            for (int i = 0; i < 4; ++i) { int jj = lane + 64 * i - NMETA; jj = jj < 0 ? 0 : (jj > IX_KEEP - 1 ? IX_KEEP - 1 : jj); sj[i] = (int)SEL[(size_t)qrow * IX_KEEP + jj]; }
            const int cn = SELCNT[qrow]; n = NMETA + cn;
#pragma unroll
            for (int i = 0; i < 4; ++i) { const int j = lane + 64 * i; int r = MS; if (j < NMETA) r = MS + j; else if (j < n) r = b * SEQ + sj[i] - NMETA; rows[j] = r; } }
        long qf[2][2];
        { const bool qz = l15 >= 4;
          qf[0][0] = qz ? 0l : (long)(((unsigned long long)pk_fp8x4(xa.z, xa.w) << 32) | (unsigned long long)pk_fp8x4(xa.x, xa.y));
          qf[0][1] = qz ? 0l : (long)(((unsigned long long)pk_fp8x4(xb.z, xb.w) << 32) | (unsigned long long)pk_fp8x4(xb.x, xb.y));
          qf[1][0] = qz ? 0l : (long)(((unsigned long long)pk_fp8x4(xc.z, xc.w) << 32) | (unsigned long long)pk_fp8x4(xc.x, xc.y));
          qf[1][1] = qz ? 0l : (long)(((unsigned long long)pk_fp8x4(xd.z, xd.w) << 32) | (unsigned long long)pk_fp8x4(xd.x, xd.y)); }
        LDS_WAIT();
        const int ntile = (n + 15) >> 4;
        const int nchk = (ntile + 3) >> 2;
        const unsigned kcol = (unsigned)(g * 128 + 16 * (lane & 7));
        v4u krA[8], krB[8];
#define AT_KLOAD(VR, CH) do { _Pragma("unroll") for (int i = 0; i < 8; ++i) { const unsigned ko = (unsigned)rows[64 * (CH) + 8 * i + (lane >> 3)] * 512u + kcol; VR[i] = *(const v4u*)(K8 + ko); } } while (0)
#define AT_KSTAGE(VR) do { _Pragma("unroll") for (int i = 0; i < 8; ++i) *(LAS v4u*)(Vs + (8 * i + (lane >> 3)) * 144 + (lane & 7) * 16) = VR[i]; } while (0)
#define AT_QK(CH, LIVE) do { f32x4 S4[4]; \
        _Pragma("unroll") for (int q = 0; q < 4; ++q) S4[q] = (f32x4){0.f, 0.f, 0.f, 0.f}; \
        if (LIVE) { _Pragma("unroll") for (int q = 0; q < 4; ++q) _Pragma("unroll") for (int m = 0; m < 2; ++m) { \
            const v4u kv = *(const LAS v4u*)(Vs + (16 * q + l15) * 144 + 16 * g4 + 64 * m); \
            const long k0 = (long)(((unsigned long long)kv.y << 32) | (unsigned long long)kv.x), k1 = (long)(((unsigned long long)kv.w << 32) | (unsigned long long)kv.z); \
            S4[q] = __builtin_amdgcn_mfma_f32_16x16x32_fp8_fp8(k0, qf[m][0], S4[q], 0, 0, 0); \
            S4[q] = __builtin_amdgcn_mfma_f32_16x16x32_fp8_fp8(k1, qf[m][1], S4[q], 0, 0, 0); } } \
        if (l15 < 4) { _Pragma("unroll") for (int q = 0; q < 4; ++q) _Pragma("unroll") for (int j = 0; j < 4; ++j) { const int kk = (4 * (CH) + q) * 16 + 4 * g4 + j; P[kk * 4 + l15] = kk < n ? S4[q][j] * 0.08838834764831845f : -__builtin_inff(); } } } while (0)
        AT_KLOAD(krA, 0);
        if (nchk > 1) AT_KLOAD(krB, 1);
#pragma unroll 1
        for (int ch = 0; ch < 4; ch += 2) {
            if (ch < nchk) { AT_KSTAGE(krA); if (ch + 2 < nchk) AT_KLOAD(krA, ch + 2); LDS_WAIT(); }
            AT_QK(ch, ch < nchk); LDS_WAIT();
            if (ch + 1 < nchk) { AT_KSTAGE(krB); if (ch + 3 < nchk) AT_KLOAD(krB, ch + 3); LDS_WAIT(); }
            AT_QK(ch + 1, ch + 1 < nchk); LDS_WAIT();
        }
#undef AT_KLOAD
#undef AT_KSTAGE
#undef AT_QK
        LDS_WAIT();
        {
            f32x4 pv[4]; f32x4 mx4 = (f32x4){-__builtin_inff(), -__builtin_inff(), -__builtin_inff(), -__builtin_inff()};
#pragma unroll
            for (int i = 0; i < 4; ++i) { pv[i] = *(const LAS f32x4*)(P + (lane + 64 * i) * 4);
#pragma unroll
                for (int h = 0; h < 4; ++h) mx4[h] = fmaxf(mx4[h], pv[i][h]); }
#pragma unroll
            for (int h = 0; h < 4; ++h) mx4[h] = wave_max(mx4[h]);
            f32x4 sm = (f32x4){0.f, 0.f, 0.f, 0.f};
#pragma unroll
            for (int i = 0; i < 4; ++i)
#pragma unroll
                for (int h = 0; h < 4; ++h) { const float e = __expf(pv[i][h] - mx4[h]); pv[i][h] = e; sm[h] += e; }
#pragma unroll
            for (int h = 0; h < 4; ++h) { sm[h] = wave_sum(sm[h]); sm[h] = 1.0f / sm[h]; }
            LDS_WAIT();
#pragma unroll
            for (int i = 0; i < 4; ++i)
#pragma unroll
                for (int h = 0; h < 4; ++h) P8[h * 256 + lane + 64 * i] = (unsigned char)(f8x4(pv[i][h] * sm[h] * 128.0f, 0.f, 0.f, 0.f) & 0xffu);
        }
        LDS_WAIT();
        f32x4 acc[8];
#pragma unroll
        for (int dt = 0; dt < 8; ++dt) acc[dt] = (f32x4){0.f, 0.f, 0.f, 0.f};
        const int nch = (ntile + 3) >> 2;
        const unsigned vcol = (unsigned)(g * 128 + 16 * (lane & 7));
        v4u vrA[8], vrB[8];
#define AT_VLOAD(VR, CH) do { _Pragma("unroll") for (int i = 0; i < 8; ++i) { const unsigned vo = (unsigned)rows[64 * (CH) + 8 * i + (lane >> 3)] * 512u + vcol; VR[i] = *(const v4u*)(V8 + vo); } } while (0)
#define AT_VSTAGE(VR) do { _Pragma("unroll") for (int i = 0; i < 8; ++i) *(LAS v4u*)(Vs + (8 * i + (lane >> 3)) * 144 + (lane & 7) * 16) = VR[i]; } while (0)
#define AT_PV(CH) do { _Pragma("unroll") for (int ks = 0; ks < 2; ++ks) { long pa = 0l; if (l15 < 4) pa = *(const LAS long*)(P8 + l15 * 256 + 64 * (CH) + 32 * ks + 8 * g4); \
        _Pragma("unroll") for (int dt = 0; dt < 8; ++dt) { const LAS unsigned char* tp = Vs + (32 * ks + 8 * g4 + (l15 >> 1)) * 144 + 16 * dt + 8 * (l15 & 1); \
            const v2i_t tv = __builtin_amdgcn_ds_read_tr8_b64_v2i32((LAS v2i_t*)tp); \
            acc[dt] = __builtin_amdgcn_mfma_f32_16x16x32_fp8_fp8(pa, __builtin_bit_cast(long, tv), acc[dt], 0, 0, 0); } } } while (0)
        AT_VLOAD(vrA, 0);
        if (nch > 1) AT_VLOAD(vrB, 1);
#pragma unroll 1
        for (int ch = 0; ch < nch; ch += 2) {
            AT_VSTAGE(vrA); if (ch + 2 < nch) AT_VLOAD(vrA, ch + 2);
            LDS_WAIT(); AT_PV(ch); LDS_WAIT();
            if (ch + 1 < nch) { AT_VSTAGE(vrB); if (ch + 3 < nch) AT_VLOAD(vrB, ch + 3);
                LDS_WAIT(); AT_PV(ch + 1); LDS_WAIT(); }
        }
#undef AT_VLOAD
#undef AT_VSTAGE
#undef AT_PV
        if (lane < 16) {
#pragma unroll
            for (int dt = 0; dt < 8; ++dt)
#pragma unroll
                for (int j = 0; j < 4; ++j) { const float ov = acc[dt][j] * (1.0f / 128.0f);
                    if (G7_F8) ((unsigned char*)ATT)[(size_t)qrow * D + (4 * g + j) * 128 + 16 * dt + lane] = (unsigned char)f8x4(ov, 0.f, 0.f, 0.f); else ATT[(size_t)qrow * D + (4 * g + j) * 128 + 16 * dt + lane] = (bf16)f2bf(ov); } }
        LDS_WAIT();
    }
}

__device__ __forceinline__ void ph_r1(const Ctx& c) {
    LAS unsigned* lcnt = (LAS unsigned*)(c.lds + 65536);
    if (c.tid < 8) lcnt[c.tid] = 0u;
    bf16* XN = (bf16*)(c.ws + WS_XN); const float* g = c.in[I_MOENORM]; const float* wr = c.in[I_ROUTER];
    LAS f32x4* wl = (LAS f32x4*)c.lds;
    for (int v = c.tid; v < 4096; v += 512) { const int ln = v & 63, hf = (v >> 6) & 1, k = (v >> 7) & 3, j = v >> 9; wl[v] = *(const f32x4*)(wr + (size_t)(4 * (ln + 64 * j) + k) * 8 + 4 * hf); }
    __syncthreads();
    int* TOPI = (int*)(c.ws + WS_TOP); float* TOPG = (float*)(c.ws + WS_TOP) + 65536;
    const int gw = c.bid * 8 + c.wave, NGW = c.G * 8, lane = c.lane;
    f32x4 v[8], nxt[8];
    if (gw < MS) row_load_h(v, c, gw, lane);
    for (int row = gw; row < MS; row += NGW) {
        if (row + NGW < MS) row_load_h(nxt, c, row + NGW, lane);
        float s = 0.f;
#pragma unroll
        for (int j = 0; j < 8; ++j) s += (v[j].x * v[j].x + v[j].y * v[j].y) + (v[j].z * v[j].z + v[j].w * v[j].w);
        const float rstd = 1.0f / sqrtf(wave_sum(s) * (1.f / D) + EPS);
        float lg[8];
#pragma unroll
        for (int e = 0; e < 8; ++e) lg[e] = 0.f;
        unsigned* o8 = (unsigned*)((unsigned char*)XN + (size_t)row * D) + lane;
#pragma unroll
        for (int j = 0; j < 8; ++j) { const f32x4 gg = ((const f32x4*)g)[lane + 64 * j]; const f32x4 o = v[j] * rstd * gg; o8[64 * j] = f8x4(o.x, o.y, o.z, o.w);
#pragma unroll
            for (int k = 0; k < 4; ++k) { const f32x4 w0 = wl[((j * 4 + k) * 2 + 0) * 64 + lane], w1 = wl[((j * 4 + k) * 2 + 1) * 64 + lane];
                lg[0] += o[k] * w0.x; lg[1] += o[k] * w0.y; lg[2] += o[k] * w0.z; lg[3] += o[k] * w0.w; lg[4] += o[k] * w1.x; lg[5] += o[k] * w1.y; lg[6] += o[k] * w1.z; lg[7] += o[k] * w1.w; } }
#pragma unroll
        for (int e = 0; e < 8; ++e) lg[e] = wave_sum(lg[e]);
        int i0 = 0; float v0 = lg[0];
#pragma unroll
        for (int e = 1; e < 8; ++e) if (lg[e] > v0) { v0 = lg[e]; i0 = e; }
        int i1 = -1; float v1 = -__builtin_inff();
#pragma unroll
        for (int e = 0; e < 8; ++e) if (e != i0 && lg[e] > v1) { v1 = lg[e]; i1 = e; }
        if (lane == 0) { const float e1 = __expf(v1 - v0), g0 = 1.0f / (1.0f + e1);
            TOPI[2 * row] = i0; TOPI[2 * row + 1] = i1; TOPG[2 * row] = g0; TOPG[2 * row + 1] = e1 * g0;
            __hip_atomic_fetch_add(lcnt + i0, 1u, __ATOMIC_RELAXED, __HIP_MEMORY_SCOPE_WORKGROUP); __hip_atomic_fetch_add(lcnt + i1, 1u, __ATOMIC_RELAXED, __HIP_MEMORY_SCOPE_WORKGROUP); }
#pragma unroll
        for (int j = 0; j < 8; ++j) v[j] = nxt[j];
    }
    __syncthreads();
    if (c.tid < 8) ((unsigned*)(c.ws + WS_MOET))[MT_BLKCNT + c.bid * 8 + c.tid] = lcnt[c.tid];
}
__device__ __forceinline__ void ph_r2(const Ctx& c) {
    LAS unsigned* cur = (LAS unsigned*)c.lds;
    unsigned* MT = (unsigned*)(c.ws + WS_MOET);
    LAS unsigned* tot = cur + 8; LAS unsigned* mine = cur + 16;
    if (c.tid < 24) cur[c.tid] = 0u;
    __syncthreads();
    for (int idx = c.tid; idx < c.G * 8; idx += 512) { const unsigned v = ld_agent(MT + MT_BLKCNT + idx); const int bl = idx >> 3, e = idx & 7;
        __hip_atomic_fetch_add(tot + e, v, __ATOMIC_RELAXED, __HIP_MEMORY_SCOPE_WORKGROUP); if (bl < c.bid) __hip_atomic_fetch_add(mine + e, v, __ATOMIC_RELAXED, __HIP_MEMORY_SCOPE_WORKGROUP); }
    __syncthreads();
    if (c.tid < 8) { unsigned start = 0u; for (int e = 0; e < c.tid; ++e) start += ((tot[e] + 255u) >> 8) << 8;
        cur[c.tid] = start + mine[c.tid];
        if (c.bid == 0) { const unsigned nt_e = (tot[c.tid] + 255u) >> 8, t0 = start >> 8; for (unsigned k = 0; k < nt_e; ++k) MT[MT_TILEEXP + t0 + k] = (unsigned)c.tid;
            if (c.tid == 7) MT[MT_NTILES] = t0 + nt_e; } }
    __syncthreads();
    const unsigned char* XN = c.ws + WS_XN; unsigned char* XG = c.ws + WS_XG;
    const int* TOPI = (const int*)(c.ws + WS_TOP); int* POS = (int*)(c.ws + WS_TOP) + 131072;
    const int gw = c.bid * 8 + c.wave, NGW = c.G * 8, lane = c.lane;
    v4u dv[2], nv[2]; int e0 = 0, e1 = 0, ne0 = 0, ne1 = 0;
    if (gw < MS) { e0 = TOPI[2 * gw]; e1 = TOPI[2 * gw + 1]; const v4u* src = (const v4u*)(XN + (size_t)gw * D);
#pragma unroll
        for (int j = 0; j < 2; ++j) dv[j] = src[lane + 64 * j]; }
    for (int row = gw; row < MS; row += NGW) {
        const int nrow = row + NGW;
        if (nrow < MS) { ne0 = TOPI[2 * nrow]; ne1 = TOPI[2 * nrow + 1]; const v4u* src = (const v4u*)(XN + (size_t)nrow * D);
#pragma unroll
            for (int j = 0; j < 2; ++j) nv[j] = src[lane + 64 * j]; }
        int p0 = 0, p1 = 0;
        if (lane == 0) { p0 = (int)__hip_atomic_fetch_add(cur + e0, 1u, __ATOMIC_RELAXED, __HIP_MEMORY_SCOPE_WORKGROUP); p1 = (int)__hip_atomic_fetch_add(cur + e1, 1u, __ATOMIC_RELAXED, __HIP_MEMORY_SCOPE_WORKGROUP);
            POS[2 * row] = p0; POS[2 * row + 1] = p1; }
        p0 = __shfl(p0, 0); p1 = __shfl(p1, 0);
        v4u* d0 = (v4u*)(XG + (size_t)p0 * D); v4u* d1 = (v4u*)(XG + (size_t)p1 * D);
#pragma unroll
        for (int j = 0; j < 2; ++j) { d0[lane + 64 * j] = dv[j]; d1[lane + 64 * j] = dv[j]; dv[j] = nv[j]; }
        e0 = ne0; e1 = ne1;
    }
}
struct FinRow { f32x4 h[8]; v2u y0[8], y1[8]; float g0, g1; };
__device__ __forceinline__ void fin_load(FinRow& r, const Ctx& c, int row, int lane) {
    const bf16* Y = (const bf16*)(c.ws + WS_Y); const float* TOPG = (const float*)(c.ws + WS_TOP) + 65536; const int* POS = (const int*)(c.ws + WS_TOP) + 131072;
    r.g0 = TOPG[2 * row]; r.g1 = TOPG[2 * row + 1];
    const v2u* y0 = (const v2u*)(Y + (size_t)POS[2 * row] * D) + lane; const v2u* y1 = (const v2u*)(Y + (size_t)POS[2 * row + 1] * D) + lane;
    row_load_h(r.h, c, row, lane);
#pragma unroll
    for (int j = 0; j < 8; ++j) { r.y0[j] = y0[64 * j]; r.y1[j] = y1[64 * j]; }
}
__device__ __forceinline__ void ph_final(const Ctx& c) {
    const float* g = c.in[I_FINALNORM];
    const int gw = c.bid * 8 + c.wave, NGW = c.G * 8, lane = c.lane;
    FinRow cur, nxt;
    if (gw < MS) fin_load(cur, c, gw, lane);
    for (int row = gw; row < MS; row += NGW) {
        if (row + NGW < MS) fin_load(nxt, c, row + NGW, lane);
        f32x4* xr = (f32x4*)(c.out + (size_t)row * D) + lane; f32x4 v[8]; float s = 0.f;
#pragma unroll
        for (int j = 0; j < 8; ++j) { const v2u a = cur.y0[j], bq = cur.y1[j];
            f32x4 ya, yb;
            ya.x = __builtin_bit_cast(float, a.x << 16); ya.y = __builtin_bit_cast(float, a.x & 0xffff0000u); ya.z = __builtin_bit_cast(float, a.y << 16); ya.w = __builtin_bit_cast(float, a.y & 0xffff0000u);
            yb.x = __builtin_bit_cast(float, bq.x << 16); yb.y = __builtin_bit_cast(float, bq.x & 0xffff0000u); yb.z = __builtin_bit_cast(float, bq.y << 16); yb.w = __builtin_bit_cast(float, bq.y & 0xffff0000u);
            v[j] = cur.h[j] + cur.g0 * ya + cur.g1 * yb; s += (v[j].x * v[j].x + v[j].y * v[j].y) + (v[j].z * v[j].z + v[j].w * v[j].w); }
        const float rstd = 1.0f / sqrtf(wave_sum(s) * (1.f / D) + EPS);
#pragma unroll
        for (int j = 0; j < 8; ++j) { const f32x4 gg = ((const f32x4*)g)[lane + 64 * j]; xr[64 * j] = v[j] * rstd * gg; }
        cur = nxt;
    }
}

template <int K>
__device__ __forceinline__ void meta_resid(const Ctx& c, const bf16* A, const bf16* Bt) {
    float* hm = (float*)(c.ws + WS_HMPAD); LAS f32x4* part = (LAS f32x4*)c.lds;
    const int lane = c.lane, g4 = lane >> 4, l15 = lane & 15;
    constexpr int KS = K / 32 / 8;
    for (int nt = c.bid; nt < 128; nt += c.G) {
        const bf16* ap = A + (size_t)(MS + l15) * K + c.wave * KS * 32 + 8 * g4; const bf16* bp = Bt + (size_t)(nt * 16 + l15) * K + c.wave * KS * 32 + 8 * g4;
        f32x4 acc = (f32x4){0.f, 0.f, 0.f, 0.f};
        for (int k0 = 0; k0 < KS; k0 += 8) { bf16x8 af[8], bfr[8];
#pragma unroll
            for (int i = 0; i < 8; ++i) { const int kk = k0 + i < KS ? k0 + i : KS - 1; af[i] = *(const bf16x8*)(ap + kk * 32); bfr[i] = *(const bf16x8*)(bp + kk * 32); }
#pragma unroll
            for (int i = 0; i < 8; ++i) if (k0 + i < KS) acc = __builtin_amdgcn_mfma_f32_16x16x32_bf16(af[i], bfr[i], acc, 0, 0, 0); }
        part[c.wave * 64 + lane] = acc;
        __syncthreads();
        if (c.wave == 0) { f32x4 t = part[lane];
#pragma unroll
            for (int w = 1; w < 8; ++w) t += part[w * 64 + lane];
#pragma unroll
            for (int j = 0; j < 4; ++j) { float* p = hm + (size_t)(4 * g4 + j) * D + nt * 16 + l15; *p = *p + t[j]; } }
        __syncthreads();
    }
}
template <int NJ>
__device__ __forceinline__ void meta_swiglu(const Ctx& c, const bf16* A, const bf16* Wgu, bf16* O, int ldo) {
    LAS f32x4* part = (LAS f32x4*)c.lds;
    const int lane = c.lane, g4 = lane >> 4, l15 = lane & 15;
    for (int it = c.bid; it < NJ * 8; it += c.G) {
        const int jg = it >> 3, sub = it & 7;
        const bf16* ap = A + (size_t)(MS + l15) * D + c.wave * 256 + 8 * g4; const bf16* gp = Wgu + (size_t)(256 * jg + 16 * sub + l15) * D + c.wave * 256 + 8 * g4; const bf16* up = gp + (size_t)128 * D;
        f32x4 ag = (f32x4){0.f, 0.f, 0.f, 0.f}, au = ag;
        bf16x8 af[8], gf[8], uf[8];
#pragma unroll
        for (int i = 0; i < 8; ++i) { af[i] = *(const bf16x8*)(ap + i * 32); gf[i] = *(const bf16x8*)(gp + i * 32); uf[i] = *(const bf16x8*)(up + i * 32); }
#pragma unroll
        for (int i = 0; i < 8; ++i) { ag = __builtin_amdgcn_mfma_f32_16x16x32_bf16(af[i], gf[i], ag, 0, 0, 0); au = __builtin_amdgcn_mfma_f32_16x16x32_bf16(af[i], uf[i], au, 0, 0, 0); }
        part[c.wave * 64 + lane] = ag; part[512 + c.wave * 64 + lane] = au;
        __syncthreads();
        if (c.wave == 0) { f32x4 tg = part[lane], tu = part[512 + lane];
#pragma unroll
            for (int w = 1; w < 8; ++w) { tg += part[w * 64 + lane]; tu += part[512 + w * 64 + lane]; }
#pragma unroll
            for (int j = 0; j < 4; ++j) O[(size_t)(MS + 4 * g4 + j) * ldo + 128 * jg + 16 * sub + l15] = (bf16)f2bf(siluf_(tg[j]) * tu[j]); }
        __syncthreads();
    }
}

template <int K>
__device__ __forceinline__ void meta_resid_f8(const Ctx& c, const unsigned char* A, const unsigned char* Bt, float sc) {
    float* hm = (float*)(c.ws + WS_HMPAD); LAS f32x4* part = (LAS f32x4*)c.lds;
    const int lane = c.lane, g4 = lane >> 4, l15 = lane & 15;
    constexpr int KS = K / 32 / 8;
    for (int nt = c.bid; nt < 128; nt += c.G) {
        const unsigned char* ap = A + (size_t)(MS + l15) * K + c.wave * KS * 32 + 8 * g4; const unsigned char* bp = Bt + (size_t)(nt * 16 + l15) * K + c.wave * KS * 32 + 8 * g4;
        f32x4 acc = (f32x4){0.f, 0.f, 0.f, 0.f};
        for (int k0 = 0; k0 < KS; k0 += 8) { long af[8], bfr[8];
#pragma unroll
            for (int i = 0; i < 8; ++i) { const int kk = k0 + i < KS ? k0 + i : KS - 1; af[i] = *(const long*)(ap + kk * 32); bfr[i] = *(const long*)(bp + kk * 32); }
#pragma unroll
            for (int i = 0; i < 8; ++i) if (k0 + i < KS) acc = __builtin_amdgcn_mfma_f32_16x16x32_fp8_fp8(af[i], bfr[i], acc, 0, 0, 0); }
        part[c.wave * 64 + lane] = acc;
        __syncthreads();
        if (c.wave == 0) { f32x4 t = part[lane];
#pragma unroll
            for (int w = 1; w < 8; ++w) t += part[w * 64 + lane];
#pragma unroll
            for (int j = 0; j < 4; ++j) { float* p = hm + (size_t)(4 * g4 + j) * D + nt * 16 + l15; *p = *p + t[j] * sc; } }
        __syncthreads();
    }
}
template <int NJ>
__device__ __forceinline__ void meta_swiglu_f8(const Ctx& c, const unsigned char* A, const unsigned char* Wgu, unsigned char* O, int ldo, float sc) {
    LAS f32x4* part = (LAS f32x4*)c.lds;
    const int lane = c.lane, g4 = lane >> 4, l15 = lane & 15;
    for (int it = c.bid; it < NJ * 8; it += c.G) {
        const int jg = it >> 3, sub = it & 7;
        const unsigned char* ap = A + (size_t)(MS + l15) * D + c.wave * 256 + 8 * g4; const unsigned char* gp = Wgu + (size_t)(256 * jg + 16 * sub + l15) * D + c.wave * 256 + 8 * g4; const unsigned char* up = gp + (size_t)128 * D;
        f32x4 ag = (f32x4){0.f, 0.f, 0.f, 0.f}, au = ag;
        long af[8], gf[8], uf[8];
#pragma unroll
        for (int i = 0; i < 8; ++i) { af[i] = *(const long*)(ap + i * 32); gf[i] = *(const long*)(gp + i * 32); uf[i] = *(const long*)(up + i * 32); }
#pragma unroll
        for (int i = 0; i < 8; ++i) { ag = __builtin_amdgcn_mfma_f32_16x16x32_fp8_fp8(af[i], gf[i], ag, 0, 0, 0); au = __builtin_amdgcn_mfma_f32_16x16x32_fp8_fp8(af[i], uf[i], au, 0, 0, 0); }
        part[c.wave * 64 + lane] = ag; part[512 + c.wave * 64 + lane] = au;
        __syncthreads();
        if (c.wave == 0) { f32x4 tg = part[lane], tu = part[512 + lane];
#pragma unroll
            for (int w = 1; w < 8; ++w) { tg += part[w * 64 + lane]; tu += part[512 + w * 64 + lane]; }
#pragma unroll
            for (int j = 0; j < 4; ++j) O[(size_t)(MS + 4 * g4 + j) * ldo + 128 * jg + 16 * sub + l15] = (unsigned char)(f8x4(siluf_(tg[j] * sc) * (tu[j] * sc), 0.f, 0.f, 0.f) & 0xffu); }
        __syncthreads();
    }
}

template <int NJ>
__device__ __forceinline__ void meta_swiglu_i8(const Ctx& c, const unsigned char* A, const float* xs, const unsigned char* Wgu, const float* wsc, unsigned char* O, int ldo) {
    LAS v4i_t* part = (LAS v4i_t*)c.lds;
    const int lane = c.lane, g4 = lane >> 4, l15 = lane & 15;
    for (int it = c.bid; it < NJ * 8; it += c.G) {
        const int jg = it >> 3, sub = it & 7;
        const unsigned char* ap = A + (size_t)(MS + l15) * D + c.wave * 256 + 16 * g4; const unsigned char* gp = Wgu + (size_t)(256 * jg + 16 * sub + l15) * D + c.wave * 256 + 16 * g4; const unsigned char* up = gp + (size_t)128 * D;
        v4i_t ag = (v4i_t){0, 0, 0, 0}, au = ag;
        v4i_t af[4], gf[4], uf[4];
#pragma unroll
        for (int i = 0; i < 4; ++i) { af[i] = *(const v4i_t*)(ap + i * 64); gf[i] = *(const v4i_t*)(gp + i * 64); uf[i] = *(const v4i_t*)(up + i * 64); }
#pragma unroll
        for (int i = 0; i < 4; ++i) { ag = __builtin_amdgcn_mfma_i32_16x16x64_i8(af[i], gf[i], ag, 0, 0, 0); au = __builtin_amdgcn_mfma_i32_16x16x64_i8(af[i], uf[i], au, 0, 0, 0); }
        part[c.wave * 64 + lane] = ag; part[512 + c.wave * 64 + lane] = au;
        __syncthreads();
        if (c.wave == 0) { v4i_t tg = part[lane], tu = part[512 + lane];
#pragma unroll
            for (int w = 1; w < 8; ++w) { tg += part[w * 64 + lane]; tu += part[512 + w * 64 + lane]; }
            const float sg = wsc[256 * jg + 16 * sub + l15], su = wsc[256 * jg + 128 + 16 * sub + l15];
#pragma unroll
            for (int j = 0; j < 4; ++j) { const float rs = xs[MS + 4 * g4 + j];
                O[(size_t)(MS + 4 * g4 + j) * ldo + 128 * jg + 16 * sub + l15] = (unsigned char)(f8x4(siluf_((float)tg[j] * rs * sg) * ((float)tu[j] * rs * su), 0.f, 0.f, 0.f) & 0xffu); } }
        __syncthreads();
    }
}

enum { PH_PRE = 0, PH_PRE2, PH_G1, PH_CONV, PH_G2, PH_SCANA, PH_SCANC, PH_GLA2, PH_GLA3, PH_G3, PH_NORM1, PH_G4, PH_G5, PH_NORM2, PH_G6, PH_ROPE, PH_INDEX, PH_ATTN, PH_G7,
       PH_R1, PH_R2, PH_M0A, PH_M0B, PH_M1B, PH_M2B, PH_FINAL, NPH };

__global__ void __launch_bounds__(512, 2) mega(Args args) {
    extern __shared__ __attribute__((aligned(16))) unsigned char lds_raw[];
    Ctx c; c.out = args.out; c.ws = args.ws; c.lds = (LAS unsigned char*)lds_raw;
    c.tid = threadIdx.x; c.lane = c.tid & 63; c.wave = __builtin_amdgcn_readfirstlane(c.tid >> 6); c.G = gridDim.x; c.bid = blockIdx.x;
    volatile LAS unsigned* misc = (volatile LAS unsigned*)(c.lds + LDS_MISC);
    if (c.tid < 64) misc[c.tid] = 0u;
    __syncthreads();
    const int lo = args.ph_lo, hi = args.ph_hi;
    XcdBarrier bar; bar.bar = (unsigned*)(c.ws + WS_CTL) + CW_BAR; bar.x = 0; bar.st = misc + 8;
    if (hi - lo > 1) bar = xcd_barrier_post((unsigned*)(c.ws + WS_CTL) + CW_BAR, misc + 8);
#ifndef PH_ENABLE
#define PH_ENABLE 0xFFFFFFFFull
#endif
#define IN(k) ((((PH_ENABLE) >> (k)) & 1ull) && lo <= (k) && (k) < hi)
#define SEAM(k) do { if (IN(k) && IN((k) + 1)) xcd_barrier(bar); else __syncthreads(); } while (0)
    unsigned char* ws = c.ws;
    bf16* XN = (bf16*)(ws + WS_XN); float* HMPAD = (float*)(ws + WS_HMPAD);

#ifndef DUP_MASK
#define DUP_MASK 0ull
#endif
#ifndef PROBE_MULT
#define PROBE_MULT 0
#endif
#define PROBE_ON(k) (PROBE_MULT > 0 && (((DUP_MASK) >> (k)) & 1ull) && c.bid == 0 && c.tid == 0)
#define PHASE(k, ...) if (IN(k)) { if (PROBE_ON(k)) { const unsigned long long t_ = __builtin_amdgcn_s_memrealtime(); misc[16] = (unsigned)t_; misc[17] = (unsigned)(t_ >> 32); } \
    __VA_ARGS__ SEAM(k); \
    if (PROBE_ON(k)) { const unsigned long long t0_ = (unsigned long long)misc[16] | ((unsigned long long)misc[17] << 32), d_ = __builtin_amdgcn_s_memrealtime() - t0_; \
        const unsigned long long a_ = ((unsigned long long)misc[18] | ((unsigned long long)misc[19] << 32)) + d_; misc[18] = (unsigned)a_; misc[19] = (unsigned)(a_ >> 32); } }
    PHASE(PH_PRE, ph_pre(c);)
    PHASE(PH_PRE2, ph_pre2(c);)
    PHASE(PH_G1,
        { gm::DenseSched S{129, NABP / 256, c.G, c.bid, (const char*)(ws + WS_XN), (const char*)(ws + WS_WINAB), D, D, 0};
        gm::EpiBf16I8 E{(bf16*)(ws + WS_Z0), NABP, (const float*)(ws + WS_XS), (const float*)(ws + WS_WSC) + WMX_AB};
        gm::gemm_phase<gm::EpiBf16I8, gm::DenseSched, 2>(c.lds, S, E, D / 128, D, D); })
    PHASE(PH_CONV, ph_conv(c);)
    PHASE(PH_G2,
        { gm::DenseSched S{129, 8, c.G, c.bid, (const char*)(ws + WS_XC), (const char*)(ws + WS_WRI), 1024 * 2, 256 * 2, 1};
        gm::EpiBf16 E{(bf16*)(ws + WS_RI), D, 0};
        gm::gemm_phase(c.lds, S, E, 4, 1024 * 2, 256 * 2); })
#define SUBPROBE(id, ...) { if (PROBE_ON(32 + (id))) { const unsigned long long t_ = __builtin_amdgcn_s_memrealtime(); misc[16] = (unsigned)t_; misc[17] = (unsigned)(t_ >> 32); } \
    __VA_ARGS__ \
    if (PROBE_ON(32 + (id))) { const unsigned long long t0_ = (unsigned long long)misc[16] | ((unsigned long long)misc[17] << 32), d_ = __builtin_amdgcn_s_memrealtime() - t0_; \
        const unsigned long long a_ = ((unsigned long long)misc[18] | ((unsigned long long)misc[19] << 32)) + d_; misc[18] = (unsigned)a_; misc[19] = (unsigned)(a_ >> 32); } }
    PHASE(PH_SCANA, SUBPROBE(0, ph_scan_a(c);) SUBPROBE(1, ph_gla0(c);))
    PHASE(PH_SCANC, SUBPROBE(2, ph_scan_c(c);) SUBPROBE(3, ph_gla1(c);))
    PHASE(PH_GLA2, ph_gla2(c);)
    PHASE(PH_GLA3, ph_gla3(c);)
    PHASE(PH_G3,
        { if (G3_F8) { meta_resid_f8<D>(c, ws + WS_MIX, ws + WS_WOUTAB, 1.0f / MOE_WS_GU);
            gm::DenseSched S{128, 8, c.G, c.bid, (const char*)(ws + WS_MIX), (const char*)(ws + WS_WOUTAB), D, D, 0};
            gm::EpiResid E{c.in[I_X], (bf16*)(ws + WS_HB), HMPAD, 1.0f / MOE_WS_GU};
            gm::gemm_phase<gm::EpiResid, gm::DenseSched, 1>(c.lds, S, E, D / 128, D, D); }
        else { meta_resid<D>(c, (const bf16*)(ws + WS_MIX), (const bf16*)(ws + WS_WOUTAB));
        gm::DenseSched S{128, 8, c.G, c.bid, (const char*)(ws + WS_MIX), (const char*)(ws + WS_WOUTAB), D * 2, D * 2, 0};
        gm::EpiResid E{c.in[I_X], (bf16*)(ws + WS_HB), HMPAD};
        gm::gemm_phase(c.lds, S, E, D / 64, D * 2, D * 2); } })
    PHASE(PH_NORM1, norm_phase_i8(c, c.out, c.in[I_FFNNORM]);)
    PHASE(PH_G4,
        { meta_swiglu_i8<44>(c, ws + WS_XN, (const float*)(ws + WS_XS), ws + WS_WGU, (const float*)(ws + WS_WSC) + WMX_GU, ws + WS_ACT, DFF);
        gm::DenseSched S{128, 44, c.G, c.bid, (const char*)(ws + WS_XN), (const char*)(ws + WS_WGU), D, D, 0};
        gm::EpiSwigluI8 E{ws + WS_ACT, DFF, (const float*)(ws + WS_XS), (const float*)(ws + WS_WSC) + WMX_GU};
        gm::gemm_phase<gm::EpiSwigluI8, gm::DenseSched, 2>(c.lds, S, E, D / 128, D, D); })
    PHASE(PH_G5,
        { meta_resid_f8<DFF>(c, ws + WS_ACT, ws + WS_WDOWN, 1.0f / MOE_WS_D);
        gm::DenseSched S{128, 8, c.G, c.bid, (const char*)(ws + WS_ACT), (const char*)(ws + WS_WDOWN), DFF, DFF, 0};
        gm::EpiResid E{nullptr, (bf16*)(ws + WS_HB), HMPAD, 1.0f / MOE_WS_D};
        gm::gemm_phase<gm::EpiResid, gm::DenseSched, true>(c.lds, S, E, DFF / 128, DFF, DFF); })
    PHASE(PH_NORM2, norm_phase_i8(c, c.out, c.in[I_CNORM]);)
    PHASE(PH_G6,
        { gm::DenseSched S{129, NCP / 256, c.G, c.bid, (const char*)(ws + WS_XN), (const char*)(ws + WS_WINC), D, D, 0};
        gm::EpiBf16I8 E{(bf16*)(ws + WS_Z1), NCP, (const float*)(ws + WS_XS), (const float*)(ws + WS_WSC) + WMX_C};
        gm::gemm_phase<gm::EpiBf16I8, gm::DenseSched, 2>(c.lds, S, E, D / 128, D, D); })
    PHASE(PH_ROPE, ph_rope(c);)
    PHASE(PH_INDEX, if (c.wave < 4) { ph_moecvt(c); ph_index(c); } else { ph_index(c); ph_moecvt(c); })
    PHASE(PH_ATTN, ph_attn(c);)
    PHASE(PH_G7,
        { if (G7_F8) { gm::DenseSched S{128, 8, c.G, c.bid, (const char*)(ws + WS_ATT), (const char*)(ws + WS_WOUTC), D, D, 0};
            gm::EpiResid E{nullptr, (bf16*)(ws + WS_HB), HMPAD, 1.0f / MOE_WS_GU};
            gm::gemm_phase<gm::EpiResid, gm::DenseSched, 1>(c.lds, S, E, D / 128, D, D); }
        else { gm::DenseSched S{128, 8, c.G, c.bid, (const char*)(ws + WS_ATT), (const char*)(ws + WS_WOUTC), D * 2, D * 2, 0};
        gm::EpiResid E{nullptr, (bf16*)(ws + WS_HB), HMPAD};
        gm::gemm_phase(c.lds, S, E, D / 64, D * 2, D * 2); } })
    PHASE(PH_R1, ph_r1(c);)
    PHASE(PH_R2, ph_r2(c);)
    constexpr size_t ACT2_BUF = (size_t)104 * 256 * DEXP;
#define MOE_LAYOUT const int ntl = (int)ld_agent((const unsigned*)(ws + WS_MOET) + MT_NTILES); const int mt0 = ntl < 96 ? ntl : 96, mrem = ntl - mt0, mt2 = mrem < 64 ? mrem : 64; \
        int mt1 = mrem - mt2; mt1 = mt1 > 104 ? 104 : mt1; const int mts[3] = {mt0, mt1, mt2}, mst[3] = {0, mt0, mt0 + mt1}; int mrb = 8 * (mt1 - 96); mrb = mrb < 0 ? 0 : mrb;
#define MOE_A(p) { MOE_LAYOUT \
        gm::MoeSched S{mts[p], 56, c.G, c.bid, (const char*)(ws + WS_XG), D, mst[p], (const char*)(ws + WS_WMGU), D, (size_t)14336 * D, (const unsigned*)(ws + WS_MOET) + MT_TILEEXP, mst[p], \
            (p) == 2 ? mrb : 0, ((p) == 2 && mrb > 0) ? 3 : 0}; \
        gm::EpiSwigluF8 E{ws + WS_ACT2 + ((p) & 1) * ACT2_BUF, DEXP, 1.0f / MOE_WS_GU}; \
        gm::gemm_phase<gm::EpiSwigluF8, gm::MoeSched, true>(c.lds, S, E, D / 128, D, D); }
#define MOE_B(p) { MOE_LAYOUT \
        gm::MoeSched S{mts[p], 8, c.G, c.bid, (const char*)(ws + WS_ACT2 + ((p) & 1) * ACT2_BUF), DEXP, 0, (const char*)(ws + WS_WMD), DEXP, (size_t)D * DEXP, (const unsigned*)(ws + WS_MOET) + MT_TILEEXP, mst[p]}; \
        gm::EpiBf16 E{(bf16*)(ws + WS_Y), D, mst[p] * 256, 1.0f / MOE_WS_D}; \
        gm::gemm_phase<gm::EpiBf16, gm::MoeSched, true>(c.lds, S, E, DEXP / 128, DEXP, DEXP); }
    PHASE(PH_M0A, MOE_A(0))
    PHASE(PH_M0B, MOE_B(0) __syncthreads(); MOE_A(1))
    PHASE(PH_M1B, MOE_B(1) __syncthreads(); MOE_A(2))
    PHASE(PH_M2B, MOE_B(2))
    PHASE(PH_FINAL, ph_final(c);)
    if (PROBE_MULT > 0 && c.bid == 0 && c.tid == 0) { const unsigned long long a_ = ((unsigned long long)misc[18] | ((unsigned long long)misc[19] << 32)) * (unsigned long long)(PROBE_MULT);
        const unsigned long long t0_ = __builtin_amdgcn_s_memrealtime(); while (__builtin_amdgcn_s_memrealtime() - t0_ < a_) __builtin_amdgcn_s_sleep(32); }
#undef IN
#undef SEAM
}

extern "C" void kernel_launch(void* const* d_in, const int* in_sizes, int n_in, void* d_out, int out_size, void* d_ws, size_t ws_size, hipStream_t stream) {
    static int grid = 0;
    if (grid == 0) {
        if (n_in != 28 || ws_size < WS_END) { fprintf(stderr, "kernel_launch: need 28 inputs and >= %zu bytes of workspace; got %d, %zu\n", (size_t)WS_END, n_in, ws_size); }
        int dev = 0, cus = 0, per_cu = 0;
        hipGetDevice(&dev); hipDeviceGetAttribute(&cus, hipDeviceAttributeMultiprocessorCount, dev);
        if (hipFuncSetAttribute((const void*)mega, hipFuncAttributeMaxDynamicSharedMemorySize, LDS_BYTES) != hipSuccess) fprintf(stderr, "kernel_launch: hipFuncSetAttribute failed\n");
        if (hipOccupancyMaxActiveBlocksPerMultiprocessor(&per_cu, (const void*)mega, 512, LDS_BYTES) != hipSuccess || per_cu < 1) fprintf(stderr, "kernel_launch: occupancy query says %d\n", per_cu);
        (void)hipGetLastError();
        grid = cus > 0 ? cus : 256;
        if (grid % 8) grid -= grid % 8;
    }
    hipMemsetAsync((char*)d_ws + WS_CTL, 0, 1 * MiB, stream);
    Args a{};
    for (int i = 0; i < 28; ++i) a.in[i] = (const float*)d_in[i];
    a.out = (float*)d_out; a.ws = (unsigned char*)d_ws; a.dup = (DUP_MASK);
#if N_LAUNCH_MODE == 1
    a.ph_lo = 0; a.ph_hi = NPH;
    hipLaunchKernelGGL(mega, dim3(grid), dim3(512), LDS_BYTES, stream, a);
#else
    for (int p = 0; p < NPH; ++p) { a.ph_lo = p; a.ph_hi = p + 1; hipLaunchKernelGGL(mega, dim3(grid), dim3(512), LDS_BYTES, stream, a); }
#endif
    const hipError_t le = hipPeekAtLastError();
    if (le != hipSuccess) fprintf(stderr, "kernel_launch: launch failed: %s\n", hipGetErrorName(le));
}
```
